# Optimizing an MI355X kernel written in HIP

```python
import math
import jax, jax.numpy as jnp
from jax import lax
import numpy as np

D_MODEL = 1024
BATCH = 2
SEQ = 8192
DEPTH = 2

GRID_W = 64
CTX_LEN = 256
NORM_EPS = 1e-6
N_MOD = 6

DN_HEADS = 4
DN_HEAD_DIM = 128
DN_WIDTH = DN_HEADS * DN_HEAD_DIM
DN_CHUNK = 64
SHORT_CONV = 3

FN_GROUPS = 4
FN_GROUP_DIM = 64
FN_WIDTH = FN_GROUPS * FN_GROUP_DIM

HY_WIDTH = 256
HY_ORDER = 2
HY_EMB_DIM = 33
HY_BANDS = (HY_EMB_DIM - 1) // 2
HY_FILTER_HIDDEN = 64
HY_FAST_DECAY_PCT = 0.3
HY_SLOW_DECAY_PCT = 1.5
HY_DECAY_TARGET = 1e-2

N_BRANCHES = 3
D_FF = 4 * D_MODEL

OFF_Q = 0
OFF_K = OFF_Q + DN_WIDTH
OFF_V = OFF_K + DN_WIDTH
OFF_Z = OFF_V + DN_WIDTH
OFF_BETA = OFF_Z + DN_WIDTH
OFF_A = OFF_BETA + 2 * DN_HEADS
OFF_FN = OFF_A + 2 * DN_HEADS
OFF_HY = OFF_FN + FN_WIDTH
OFF_GATE = OFF_HY + (HY_ORDER + 1) * HY_WIDTH
IN_WIDTH = OFF_GATE + N_BRANCHES * D_MODEL

kernel_name = 'hybrid_deltanet_fnet_hyena_prefix_dit'


def rms_norm(x, gain):
    xf = x.astype(jnp.float32)
    return xf * lax.rsqrt(jnp.mean(xf * xf, axis=-1, keepdims=True) + NORM_EPS) * gain.astype(jnp.float32)


def modulate(h, gain, shift, scale):
    y = rms_norm(h, gain) * (1.0 + scale.astype(jnp.float32)) + shift.astype(jnp.float32)
    return y.astype(h.dtype)


def l2_normalize(t):
    return t * lax.rsqrt(jnp.sum(t * t, axis=-1, keepdims=True) + NORM_EPS)


def grid_dwconv(x, w, rows, cols):
    b, n, ch = x.shape
    y = lax.conv_general_dilated(x.reshape(b, rows, cols, ch), w[:, :, None, :].astype(x.dtype), (1, 1), 'SAME',
                                 dimension_numbers=('NHWC', 'HWIO', 'NHWC'), feature_group_count=ch)
    return y.reshape(b, n, ch)


def seq_dwconv(x, w):
    ch = x.shape[-1]
    return lax.conv_general_dilated(x, w[:, None, :].astype(x.dtype), (1,), 'SAME',
                                    dimension_numbers=('NWC', 'WIO', 'NWC'), feature_group_count=ch)


def delta_prepare(p, conv_w, rows, cols, a_log, dt_bias):
    b, n, _ = p.shape
    f32 = jnp.float32
    qkv = jax.nn.silu(grid_dwconv(p[..., OFF_Q:OFF_Z], conv_w, rows, cols).astype(f32))
    qkv = qkv.reshape(b, n, 3, DN_HEADS, DN_HEAD_DIM)
    q = l2_normalize(qkv[:, :, 0]) * DN_HEAD_DIM ** -0.5
    k = l2_normalize(qkv[:, :, 1])
    v = qkv[:, :, 2]
    beta = jax.nn.sigmoid(p[..., OFF_BETA:OFF_A].astype(f32)).reshape(b, n, 2, DN_HEADS)
    a = p[..., OFF_A:OFF_FN].astype(f32).reshape(b, n, 2, DN_HEADS)
    g = -jnp.exp(a_log.astype(f32)) * jax.nn.softplus(a + dt_bias.astype(f32))
    return q, k, v, beta, g


def gated_delta_rule(q, k, v, beta, g, s0):
    b, n_tok, h, dk = q.shape
    dv = v.shape[-1]
    n_chunk = n_tok // DN_CHUNK

    def chunks(t):
        t = t.reshape((b, n_chunk, DN_CHUNK, h) + t.shape[3:])
        return jnp.moveaxis(t, (1, 3), (0, 2))

    qc, kc, vc, bc, gc = chunks(q), chunks(k), chunks(v), chunks(beta), chunks(g)
    G = jnp.cumsum(gc, axis=-1)
    idx = jnp.arange(DN_CHUNK)
    incl = idx[:, None] >= idx[None, :]
    strict = idx[:, None] > idx[None, :]
    decay = jnp.exp(jnp.where(incl, G[..., :, None] - G[..., None, :], -jnp.inf))
    kb = kc * bc[..., None]
    lhs = jnp.eye(DN_CHUNK, dtype=jnp.float32) + jnp.where(
        strict, jnp.einsum('nbhik,nbhjk->nbhij', kb, kc) * decay, 0.0)
    u_in = lax.linalg.triangular_solve(lhs, vc * bc[..., None], left_side=True, lower=True, unit_diagonal=True)
    w_in = lax.linalg.triangular_solve(lhs, kb * jnp.exp(G)[..., None], left_side=True, lower=True,
                                       unit_diagonal=True)
    qk = jnp.einsum('nbhik,nbhjk->nbhij', qc, kc) * decay
    q_dec = qc * jnp.exp(G)[..., None]
    k_dec = kc * jnp.exp(G[..., -1:] - G)[..., None]
    g_last = jnp.exp(G[..., -1])

    def step(state, inp):
        q_d, k_d, u0, w0, qk_c, gl = inp
        u = u0 - jnp.einsum('bhck,bhkv->bhcv', w0, state)
        o = jnp.einsum('bhck,bhkv->bhcv', q_d, state) + jnp.einsum('bhij,bhjv->bhiv', qk_c, u)
        state = state * gl[..., None, None] + jnp.einsum('bhck,bhcv->bhkv', k_d, u)
        return state, o

    s_final, o = lax.scan(step, s0, (q_dec, k_dec, u_in, w_in, qk, g_last))
    o = jnp.moveaxis(o, (0, 2), (1, 3)).reshape(b, n_tok, h, dv)
    return o, s_final


def bidir_delta(q, k, v, beta, g, s0_fwd, s0_bwd):
    o_f, s_f = gated_delta_rule(q, k, v, beta[:, :, 0], g[:, :, 0], s0_fwd)
    flip = lambda t: jnp.flip(t, axis=1)
    o_b, s_b = gated_delta_rule(flip(q), flip(k), flip(v), flip(beta[:, :, 1]), flip(g[:, :, 1]), s0_bwd)
    return o_f + flip(o_b), s_f, s_b


def fourier_mix(p):
    b, n, _ = p.shape
    pg = p.astype(jnp.float32).reshape(b, n, FN_GROUPS, FN_GROUP_DIM)
    return jnp.fft.fft2(pg, axes=(1, 3), norm='ortho').real.reshape(b, n, FN_WIDTH)


def hyena_kernel_rfft(n, w1, b1, freq1, w2, b2, freq2, w3):
    f32 = jnp.float32
    pos = jnp.arange(n, dtype=f32)
    t = pos / max(n - 1, 1)
    bands = jnp.linspace(1e-4, HY_BANDS - 1, HY_BANDS, dtype=f32)
    ang = (2.0 * math.pi / n) * pos[:, None] * bands[None, :]
    feats = jnp.concatenate([t[:, None], jnp.cos(ang), -jnp.sin(ang)], axis=-1)
    hid = jnp.sin(freq1.astype(f32) * (feats @ w1.astype(f32) + b1.astype(f32)))
    hid = jnp.sin(freq2.astype(f32) * (hid @ w2.astype(f32) + b2.astype(f32)))
    filt = (hid @ w3.astype(f32)).reshape(n, 2, HY_ORDER, HY_WIDTH)
    min_decay = math.log(HY_DECAY_TARGET) / HY_SLOW_DECAY_PCT
    max_decay = math.log(HY_DECAY_TARGET) / HY_FAST_DECAY_PCT
    deltas = jnp.abs(jnp.linspace(min_decay, max_decay, HY_ORDER * HY_WIDTH, dtype=f32)).reshape(HY_ORDER, HY_WIDTH)
    filt = filt * jnp.exp(-t[:, None, None, None] * deltas[None, None])
    fwd, bwd = filt[:, 0], filt[:, 1]
    kern = jnp.concatenate([fwd, jnp.zeros((1, HY_ORDER, HY_WIDTH), f32), bwd[:0:-1]], axis=0)
    kern = kern / jnp.sum(jnp.abs(kern), axis=0, keepdims=True)
    return jnp.fft.rfft(kern, axis=0)


def fft_conv(u, k_freq):
    n = u.shape[1]
    spec = jnp.fft.rfft(u, n=2 * n, axis=1) * k_freq[None]
    return jnp.fft.irfft(spec, n=2 * n, axis=1)[:, :n]


def hyena_branch(p, conv_w, k_freq, bias):
    parts = jnp.split(seq_dwconv(p, conv_w).astype(jnp.float32), HY_ORDER + 1, axis=-1)
    z = parts[HY_ORDER]
    for order in range(HY_ORDER):
        z = parts[order] * (fft_conv(z, k_freq[:, order]) + bias[order].astype(jnp.float32) * z)
    return z


def branch_merge(p, o_dn, hy_kfreq, dn_out_norm, hy_conv, hy_bias, w_branch_a, w_branch_b, w_branch_c, w_out):
    b, n, _ = p.shape
    dt = p.dtype
    z = p[..., OFF_Z:OFF_BETA].astype(jnp.float32).reshape(b, n, DN_HEADS, DN_HEAD_DIM)
    y_a = (rms_norm(o_dn, dn_out_norm) * jax.nn.silu(z)).reshape(b, n, DN_WIDTH)
    y_b = fourier_mix(p[..., OFF_FN:OFF_HY])
    y_c = hyena_branch(p[..., OFF_HY:OFF_GATE], hy_conv, hy_kfreq, hy_bias)
    gates = jax.nn.sigmoid(p[..., OFF_GATE:].astype(jnp.float32)).reshape(b, n, N_BRANCHES, D_MODEL)
    merged = (gates[:, :, 0] * (y_a.astype(dt) @ w_branch_a)
              + gates[:, :, 1] * (y_b.astype(dt) @ w_branch_b)
              + gates[:, :, 2] * (y_c.astype(dt) @ w_branch_c))
    return merged.astype(dt) @ w_out


def sq_relu_mlp(h, w1, w2):
    a = jax.nn.relu(h @ w1)
    return (a * a) @ w2


def setup_inputs(seed: int = 0) -> dict:
    key = jax.random.key(seed)
    ks = jax.random.split(key, 32)
    f32 = jnp.float32

    def nrm(i, shape, scale):
        return scale * jax.random.normal(ks[i], shape, f32)

    x = nrm(0, (BATCH, SEQ, D_MODEL), 1.0)
    c = nrm(1, (BATCH, D_MODEL), 1.0)
    ctx = nrm(2, (BATCH, CTX_LEN, D_MODEL), 1.0)
    c_ctx = nrm(3, (D_MODEL,), 1.0)
    w_mod = nrm(4, (DEPTH, D_MODEL, N_MOD * D_MODEL), D_MODEL ** -0.5)
    b_mod = nrm(5, (DEPTH, N_MOD * D_MODEL), 0.01)
    norm1 = 1.0 + nrm(6, (DEPTH, D_MODEL), 0.01)
    norm2 = 1.0 + nrm(7, (DEPTH, D_MODEL), 0.01)
    w_in = nrm(8, (DEPTH, D_MODEL, IN_WIDTH), D_MODEL ** -0.5)
    dn_conv = nrm(9, (DEPTH, SHORT_CONV, SHORT_CONV, 3 * DN_WIDTH), 1.0 / SHORT_CONV)
    dn_a_log = jnp.log(jax.random.uniform(ks[10], (DEPTH, 2, DN_HEADS), f32, 1.0, 16.0))
    dt0 = jnp.exp(jax.random.uniform(ks[11], (DEPTH, 2, DN_HEADS), f32, math.log(1e-3), math.log(1e-1)))
    dn_dt_bias = dt0 + jnp.log(-jnp.expm1(-dt0))
    dn_out_norm = 1.0 + nrm(12, (DEPTH, DN_HEAD_DIM), 0.01)
    hy_conv = nrm(13, (DEPTH, SHORT_CONV, (HY_ORDER + 1) * HY_WIDTH), SHORT_CONV ** -0.5)
    hy_w1 = nrm(14, (DEPTH, HY_EMB_DIM, HY_FILTER_HIDDEN), HY_EMB_DIM ** -0.5)
    hy_b1 = nrm(15, (DEPTH, HY_FILTER_HIDDEN), 0.1)
    hy_freq1 = 1.0 + nrm(16, (DEPTH, HY_FILTER_HIDDEN), 0.01)
    hy_w2 = nrm(17, (DEPTH, HY_FILTER_HIDDEN, HY_FILTER_HIDDEN), HY_FILTER_HIDDEN ** -0.5)
    hy_b2 = nrm(18, (DEPTH, HY_FILTER_HIDDEN), 0.1)
    hy_freq2 = 1.0 + nrm(19, (DEPTH, HY_FILTER_HIDDEN), 0.01)
    hy_w3 = nrm(20, (DEPTH, HY_FILTER_HIDDEN, 2 * HY_ORDER * HY_WIDTH), HY_FILTER_HIDDEN ** -0.5)
    hy_bias = nrm(21, (DEPTH, HY_ORDER, HY_WIDTH), 1.0)
    w_branch_a = nrm(22, (DEPTH, DN_WIDTH, D_MODEL), DN_WIDTH ** -0.5)
    w_branch_b = nrm(23, (DEPTH, FN_WIDTH, D_MODEL), FN_WIDTH ** -0.5)
    w_branch_c = nrm(24, (DEPTH, HY_WIDTH, D_MODEL), HY_WIDTH ** -0.5)
    w_out = nrm(25, (DEPTH, D_MODEL, D_MODEL), D_MODEL ** -0.5)
    w_ff1 = nrm(26, (DEPTH, D_MODEL, D_FF), D_MODEL ** -0.5)
    w_ff2 = nrm(27, (DEPTH, D_FF, D_MODEL), D_FF ** -0.5)
    final_norm = 1.0 + nrm(28, (D_MODEL,), 0.01)
    return {'x': x, 'c': c, 'ctx': ctx, 'c_ctx': c_ctx, 'w_mod': w_mod, 'b_mod': b_mod,
            'norm1': norm1, 'norm2': norm2, 'w_in': w_in, 'dn_conv': dn_conv, 'dn_a_log': dn_a_log,
            'dn_dt_bias': dn_dt_bias, 'dn_out_norm': dn_out_norm, 'hy_conv': hy_conv, 'hy_w1': hy_w1,
            'hy_b1': hy_b1, 'hy_freq1': hy_freq1, 'hy_w2': hy_w2, 'hy_b2': hy_b2, 'hy_freq2': hy_freq2,
            'hy_w3': hy_w3, 'hy_bias': hy_bias, 'w_branch_a': w_branch_a, 'w_branch_b': w_branch_b,
            'w_branch_c': w_branch_c, 'w_out': w_out, 'w_ff1': w_ff1, 'w_ff2': w_ff2,
            'final_norm': final_norm}


def reference(x, c, ctx, c_ctx, w_mod, b_mod, norm1, norm2, w_in, dn_conv, dn_a_log, dn_dt_bias,
              dn_out_norm, hy_conv, hy_w1, hy_b1, hy_freq1, hy_w2, hy_b2, hy_freq2, hy_w3, hy_bias,
              w_branch_a, w_branch_b, w_branch_c, w_out, w_ff1, w_ff2, final_norm):
    b, n_lat, _ = x.shape
    rows = n_lat // GRID_W
    n_ctx = ctx.shape[1]
    silu_c = jax.nn.silu(c)
    silu_cc = jax.nn.silu(c_ctx)
    s_zero = jnp.zeros((b, DN_HEADS, DN_HEAD_DIM, DN_HEAD_DIM), jnp.float32)
    h, hc = x, ctx
    for l in range(DEPTH):
        last = l == DEPTH - 1
        mx = jnp.split((silu_c @ w_mod[l] + b_mod[l])[:, None, :], N_MOD, axis=-1)
        mc = jnp.split((silu_cc @ w_mod[l] + b_mod[l])[None, None, :], N_MOD, axis=-1)

        p_c = modulate(hc, norm1[l], mc[0], mc[1]) @ w_in[l]
        p_x = modulate(h, norm1[l], mx[0], mx[1]) @ w_in[l]

        dn_c = delta_prepare(p_c, dn_conv[l], 1, n_ctx, dn_a_log[l], dn_dt_bias[l])
        o_c, s_fwd, s_bwd = bidir_delta(*dn_c, s_zero, s_zero)
        dn_x = delta_prepare(p_x, dn_conv[l], rows, GRID_W, dn_a_log[l], dn_dt_bias[l])
        o_x, _, _ = bidir_delta(*dn_x, s_fwd, s_bwd)

        kf_x = hyena_kernel_rfft(n_lat, hy_w1[l], hy_b1[l], hy_freq1[l], hy_w2[l], hy_b2[l], hy_freq2[l], hy_w3[l])
        y_x = branch_merge(p_x, o_x, kf_x, dn_out_norm[l], hy_conv[l], hy_bias[l],
                           w_branch_a[l], w_branch_b[l], w_branch_c[l], w_out[l])
        h = h + mx[2] * y_x
        h = h + mx[5] * sq_relu_mlp(modulate(h, norm2[l], mx[3], mx[4]), w_ff1[l], w_ff2[l])

        if not last:
            kf_c = hyena_kernel_rfft(n_ctx, hy_w1[l], hy_b1[l], hy_freq1[l], hy_w2[l], hy_b2[l], hy_freq2[l], hy_w3[l])
            y_c = branch_merge(p_c, o_c, kf_c, dn_out_norm[l], hy_conv[l], hy_bias[l],
                               w_branch_a[l], w_branch_b[l], w_branch_c[l], w_out[l])
            hc = hc + mc[2] * y_c
            hc = hc + mc[5] * sq_relu_mlp(modulate(hc, norm2[l], mc[3], mc[4]), w_ff1[l], w_ff2[l])

    return rms_norm(h, final_norm).astype(x.dtype)
```

```cpp
#include <hip/hip_runtime.h>
#include <hip/hip_cooperative_groups.h>
#include <cstdio>
namespace cg = cooperative_groups;

typedef unsigned short bf16_t;
typedef short bf16x8 __attribute__((ext_vector_type(8)));
typedef float f32x4 __attribute__((ext_vector_type(4)));
typedef float f32x2 __attribute__((ext_vector_type(2)));
typedef unsigned u32x4 __attribute__((ext_vector_type(4)));
typedef unsigned u32x2 __attribute__((ext_vector_type(2)));
#define LAS __attribute__((address_space(3)))

constexpr int D = 1024, SEQ = 8192, CTXL = 256, NLAT = 16384, NCTX = 512, MALL = 16896;
constexpr int INW = 6160, DFF = 4096;
constexpr float EPS = 1e-6f;
constexpr int NT = 512;
constexpr int LDS_BYTES = 147456;
constexpr size_t MiB = 1u << 20;

constexpr size_t WS_MOD   = 4096;
constexpr size_t WS_MODP  = WS_MOD + 2 * 3 * 6144 * 4;
constexpr size_t WS_TW    = WS_MODP + 16 * 2 * 3 * 6144 * 4;
constexpr size_t WS_HID2  = WS_TW + 16384 * 8;
constexpr size_t WS_HID2C = WS_HID2 + 2 * 8192 * 64 * 4;
constexpr size_t WS_WBA   = WS_HID2C + 256 * 64 * 4;
constexpr size_t WS_BA    = WS_WBA + 2 * 16 * 1024 * 4;
constexpr size_t WS_HC    = WS_BA + (size_t)MALL * 16 * 4;
constexpr size_t WS_DG    = WS_HC + 512 * 1024 * 4;
constexpr size_t WS_BAR   = WS_DG + 1056 * 2 * 64 * 4;
constexpr size_t WS_SMALL_END = WS_BAR + 16384;
static_assert(WS_SMALL_END <= 12 * MiB, "small region");
constexpr size_t WS_WIN   = 12 * MiB;
constexpr size_t WS_WABC  = WS_WIN + 12 * MiB + MiB / 2;
constexpr size_t WS_WOUT  = WS_WABC + 2 * MiB + MiB / 2;
constexpr size_t AB       = WS_WOUT + 2 * MiB;
constexpr size_t A_XN     = AB;
constexpr size_t A_DQ     = AB;
constexpr size_t A_DKT    = AB + 16 * MiB + MiB / 2;
constexpr size_t A_QKV    = AB + 33 * MiB;
constexpr size_t A_OF     = A_QKV;
constexpr size_t A_OB     = A_QKV + 16 * MiB + MiB / 2;
constexpr size_t A_Z      = AB + 82 * MiB + MiB / 2;
constexpr size_t A_YBT    = AB + 99 * MiB;
constexpr size_t A_YBTC   = A_YBT + 16 * MiB;
constexpr size_t A_YCT    = A_YBT + 16 * MiB + MiB / 2;
constexpr size_t A_YCTC   = A_YCT + 8 * MiB;
constexpr size_t A_BIG    = AB + 123 * MiB + 3 * MiB / 4;
constexpr size_t A_FNT    = A_BIG;
constexpr size_t A_FNTC   = A_FNT + 8 * MiB;
constexpr size_t A_HYT    = A_BIG + 8 * MiB + MiB / 4;
constexpr size_t A_HYTC   = A_HYT + 24 * MiB;
constexpr size_t A_KF     = A_BIG + 33 * MiB;
constexpr int KF_STRIDE   = 8200;
constexpr size_t A_DW     = A_BIG;
constexpr size_t A_DUT    = A_BIG + 33 * MiB;
constexpr size_t A_DQK    = A_BIG + 66 * MiB;
constexpr size_t A_FILT   = AB + 190 * MiB;
constexpr size_t A_FILTC  = AB + 222 * MiB;
constexpr size_t A_Y      = AB + 184 * MiB + MiB / 4;
constexpr size_t A_GATE   = AB + 82 * MiB + MiB / 2;
constexpr size_t A_WF1    = AB + 66 * MiB;
constexpr size_t A_WF2    = AB + 74 * MiB;
constexpr size_t A_ACT    = AB + 82 * MiB + MiB / 2;
static_assert(A_Y + (size_t)MALL * 1280 * 2 <= 256 * MiB, "ws overflow");
static_assert(A_KF + 256ull * 2 * KF_STRIDE * 8 <= 256 * MiB, "kf overflow");
static_assert(A_ACT + (size_t)MALL * 4096 * 2 <= 256 * MiB, "act overflow");
static_assert(A_GATE + (size_t)MALL * 3072 * 2 <= A_Y, "gate overlap");

struct Params { const float* in[29]; float* out; unsigned char* ws; };
typedef const __attribute__((address_space(4))) Params* KP;
enum { I_X = 0, I_C, I_CTX, I_CCTX, I_WMOD, I_BMOD, I_NORM1, I_NORM2, I_WIN, I_DNCONV, I_ALOG, I_DTB, I_DNON, I_HYCONV, I_HW1, I_HB1, I_HF1,
       I_HW2, I_HB2, I_HF2, I_HW3, I_HBIAS, I_WA, I_WB, I_WC, I_WOUT, I_FF1, I_FF2, I_FNORM };

__device__ __forceinline__ bf16_t f2bf(float f) { return __builtin_bit_cast(bf16_t, (__bf16)f); }
__device__ __forceinline__ float bf2f(bf16_t b) { return __uint_as_float(((unsigned)b) << 16); }
typedef __bf16 bf16x2_t __attribute__((ext_vector_type(2)));
__device__ __forceinline__ unsigned pk2(float lo, float hi) { bf16x2_t v = __builtin_convertvector((f32x2){lo, hi}, bf16x2_t); return __builtin_bit_cast(unsigned, v); }
__device__ __forceinline__ float lo2f(unsigned w) { return __uint_as_float(w << 16); }
__device__ __forceinline__ float hi2f(unsigned w) { return __uint_as_float(w & 0xffff0000u); }
__device__ __forceinline__ float wave_sum(float v) { for (int o = 32; o >= 1; o >>= 1) v += __shfl_xor(v, o); return v; }
__device__ __forceinline__ float sigmoidf(float x) { return __builtin_amdgcn_rcpf(1.0f + __expf(-x)); }
__device__ __forceinline__ float siluf(float x) { return x / (1.0f + __expf(-x)); }
__device__ __forceinline__ f32x2 cmul(f32x2 a, f32x2 b) { return (f32x2){a.x * b.x - a.y * b.y, a.x * b.y + a.y * b.x}; }


#define XB_TMO      128
#define XB_XCNT(j)  (256  + 64 * (j))
#define XB_XSUB(j)  (1280 + 64 * (j))
#define XB_XGEN(j)  (2304 + 64 * (j))
#define XB_TOP      3328
#define XB_TOPGEN   3392
#define XCD_BAR_WORDS 3456
#define XB_SPIN_CAP (1u << 22)
__device__ __forceinline__ unsigned xb_ld(unsigned* p)              { return __hip_atomic_load(p, __ATOMIC_RELAXED, __HIP_MEMORY_SCOPE_AGENT); }
__device__ __forceinline__ unsigned xb_add(unsigned* p, unsigned v) { return __hip_atomic_fetch_add(p, v, __ATOMIC_RELAXED, __HIP_MEMORY_SCOPE_AGENT); }
__device__ __forceinline__ unsigned xb_xcc_id() { return (unsigned)__builtin_amdgcn_s_getreg((3 << 11) | 20) & 0xFu; }
#define XB_SPIN(cond, bar) do { unsigned _sp = 0; while (cond) { __builtin_amdgcn_s_sleep(1); \
    if ((++_sp & 255u) == 0u) { if (xb_ld(&(bar)[XB_TMO])) break; if (_sp > XB_SPIN_CAP) { atomicAdd(&(bar)[XB_TMO], 1u); break; } } } } while (0)
__device__ __forceinline__ void xcd_barrier_complete(unsigned* bar, unsigned x, unsigned& nloc, unsigned& nx) {
    const unsigned G = gridDim.x * gridDim.y * gridDim.z;
    unsigned sum, cnt, mine, sp = 0u;
    for (;;) {
        sum = 0u; cnt = 0u; mine = 0u;
#pragma unroll
        for (unsigned j = 0; j < 16; ++j) { const unsigned c = xb_ld(&bar[XB_XCNT(j)]); sum += c; cnt += (c > 0u) ? 1u : 0u; mine = (j == x) ? c : mine; }
        if (sum == G) break;
        __builtin_amdgcn_s_sleep(1);
        if ((++sp & 255u) == 0u) { if (xb_ld(&bar[XB_TMO])) break; if (sp > XB_SPIN_CAP) { atomicAdd(&bar[XB_TMO], 1u); break; } }
    }
    nloc = mine > 0u ? mine : 1u; nx = cnt > 0u ? cnt : 1u;
}
__device__ __forceinline__ void xcd_barrier(unsigned* bar, volatile LAS unsigned* st) {
    asm volatile("s_waitcnt vmcnt(0)" ::: "memory");
    __syncthreads();
    if (threadIdx.x == 0) {
        const unsigned x = xb_xcc_id();
        __builtin_amdgcn_s_waitcnt(0);
        unsigned nloc = st[0], nx = st[1];
        if (nloc == 0u) { xcd_barrier_complete(bar, x, nloc, nx); st[0] = nloc; st[1] = nx; }
        const unsigned old = xb_add(&bar[XB_XSUB(x)], 1u);
        const unsigned gen = old / nloc;
        if (old + 1u == (gen + 1u) * nloc) {
            __builtin_amdgcn_fence(__ATOMIC_RELEASE, "agent");
            asm volatile("s_waitcnt vmcnt(0)" ::: "memory");
            const unsigned og = xb_add(&bar[XB_TOP], 1u);
            const unsigned tg = og / nx;
            if (og + 1u == (tg + 1u) * nx) xb_add(&bar[XB_TOPGEN], 1u);
            else XB_SPIN(xb_ld(&bar[XB_TOPGEN]) == tg, bar);
            __builtin_amdgcn_fence(__ATOMIC_ACQUIRE, "agent");
            xb_add(&bar[XB_XGEN(x)], 1u);
            asm volatile("s_waitcnt vmcnt(0)" ::: "memory");
        } else {
            XB_SPIN(xb_ld(&bar[XB_XGEN(x)]) == gen, bar);
            __builtin_amdgcn_fence(__ATOMIC_ACQUIRE, "agent");
            asm volatile("s_waitcnt vmcnt(0)" ::: "memory");
        }
    }
    __syncthreads();
}
constexpr int LDS_BARW = LDS_BYTES - 16;
#define GSYNC() xcd_barrier((unsigned*)(((KP)__builtin_amdgcn_kernarg_segment_ptr())->ws + WS_BAR), (volatile LAS unsigned*)(lds + LDS_BARW))

namespace pg8 {
constexpr int BM = 256, BK = 64, HALF = 128, HTB = HALF * BK * 2, STAGE_BYTES = 8 * HTB, NXCD = 8, WGM = 8;
__device__ __forceinline__ int lds_byte(int r, int c) { const int st = (r >> 4) * 2 + (c >> 5), rr = r & 15, cc = c & 31, ob = rr * 64 + cc * 2; return st * 1024 + (ob ^ (((ob >> 9) & 1) << 5)); }
__device__ __forceinline__ void stage_rc(int b, int& R, int& C) { const int st = b / 1024, sb = b % 1024, swz = sb ^ (((sb >> 9) & 1) << 5); R = (st >> 1) * 16 + swz / 64; C = (st & 1) * 32 + (swz % 64) / 2; }
__device__ __forceinline__ int perm32(int rho) { const int n = rho >> 4, i = rho & 15; return 8 * (i >> 2) + 4 * n + (i & 3); }
struct Unit { int pm, pn, ks; };
struct Gemm { const bf16_t* A; const bf16_t* Bt; int M, N, K; int ntile; };
struct StaticOrder {
    int nM, nN, nwg, G, c;
    __device__ void init(int M, int N, int G_, int c_) { nM = M / BM; nN = N / BM; nwg = nM * nN; G = G_; c = c_; }
    __device__ bool next(int i, Unit& u) const {
        const long L = (long)i * G + c; if (L >= nwg) return false;
        int wgid = (int)L; { const int q = nwg / NXCD, r = nwg % NXCD, xcd = wgid % NXCD, off = wgid / NXCD; wgid = (xcd < r ? xcd * (q + 1) : r * (q + 1) + (xcd - r) * q) + off; }
        const int nig = WGM * nN, gid = wgid / nig, fm = gid * WGM, gsz = (nM - fm) < WGM ? (nM - fm) : WGM;
        u.pm = fm + ((wgid % nig) % gsz); u.pn = (wgid % nig) / gsz; u.ks = 0; return true;
    }
};
struct SplitOrder {
    int G, c;
    __device__ bool next(int i, Unit& u) const { const long L = (long)i * G + c; if (L >= 128) return false; const int tile = (int)L >> 4; u.pm = 64 + (tile >> 2); u.pn = tile & 3; u.ks = (int)L & 15; return true; }
};
__device__ __forceinline__ unsigned cvt_pk_bf16(float lo, float hi) { return pk2(lo, hi); }

template <class Epi, class Sched>
__device__ __forceinline__ void gemm_phase(LAS unsigned char* lds, const Gemm g, const Sched& S, const Epi& E, const int tid) {
    const int wid = __builtin_amdgcn_readfirstlane(tid >> 6), lane = tid & 63, wr = wid >> 2, wc = wid & 3, fr = lane & 15, fq = lane >> 4;
    const int K = g.K, nt = g.ntile ? g.ntile : K / BK; const size_t ksl = (size_t)g.ntile * BK * 2;
    unsigned voffA[2], voffB[2];
#pragma unroll
    for (int i = 0; i < 2; ++i) { int R, C; stage_rc(tid * 16 + i * 8192, R, C); const int Rb = Epi::PERM ? ((R & ~31) + perm32(R & 31)) : R;
        voffA[i] = (unsigned)(R * K + C) * 2u; voffB[i] = (unsigned)(Rb * K + C) * 2u; }
    const size_t kstep = (size_t)(BK * 2);
    const size_t hstep = (size_t)HALF * K * 2;
    const size_t tstep = 2 * hstep;
    const unsigned ldsw = (unsigned)wid * 1024u;
    const int aoff = lds_byte(wr * 64 + fr, fq * 8), boff = lds_byte(wc * 32 + fr, fq * 8);
#define PG8_SA(b, h) (((b) * 2 + (h)) * HTB)
#define PG8_SB(b, h) ((4 + (b) * 2 + (h)) * HTB)
#define PG8_STAGE(bufoff, gbase, voff) do { _Pragma("unroll") for (int _i = 0; _i < 2; ++_i) \
        __builtin_amdgcn_global_load_lds((const unsigned*)((const char*)(gbase) + (voff)[_i]), (LAS unsigned*)(lds + (bufoff) + ldsw + _i * 8192), 16, 0, 0); } while (0)
#define PG8_LDA(dst, b, h) do { _Pragma("unroll") for (int m = 0; m < 4; ++m) _Pragma("unroll") for (int k = 0; k < 2; ++k) dst[m][k] = *(const LAS bf16x8*)(lds + PG8_SA(b, h) + aoff + m * 2048 + k * 1024); } while (0)
#define PG8_LDB(dst, b, h) do { _Pragma("unroll") for (int n = 0; n < 2; ++n) _Pragma("unroll") for (int k = 0; k < 2; ++k) dst[n][k] = *(const LAS bf16x8*)(lds + PG8_SB(b, h) + boff + n * 2048 + k * 1024); } while (0)
#define PG8_MMA(ai, bj, At, Bt) do { __builtin_amdgcn_s_setprio(1); _Pragma("unroll") for (int m = 0; m < 4; ++m) _Pragma("unroll") for (int n = 0; n < 2; ++n) _Pragma("unroll") for (int k = 0; k < 2; ++k) \
        acc[ai][bj][m][n] = __builtin_amdgcn_mfma_f32_16x16x32_bf16(Bt[n][k], At[m][k], acc[ai][bj][m][n], 0, 0, 0); __builtin_amdgcn_s_setprio(0); } while (0)
#define PG8_WAIT_V(n) asm volatile("s_waitcnt vmcnt(" #n ")" ::: "memory")
#define PG8_WAIT_L(n) asm volatile("s_waitcnt lgkmcnt(" #n ")" ::: "memory")
#define PG8_BAR __builtin_amdgcn_s_barrier()
#define PG8_SCHED __builtin_amdgcn_sched_barrier(0)
    Unit cur, nxt; int ui = 0;
    if (!S.next(0, cur)) return;
    f32x4 acc[2][2][4][2];
#pragma unroll
    for (int a = 0; a < 2; ++a)
#pragma unroll
        for (int b = 0; b < 2; ++b)
#pragma unroll
            for (int m = 0; m < 4; ++m)
#pragma unroll
                for (int n = 0; n < 2; ++n) acc[a][b][m][n] = (f32x4){0.f, 0.f, 0.f, 0.f};
    bf16x8 At[4][2], B0[2][2], B1[2][2];
    const char* cA = (const char*)g.A + (size_t)cur.pm * tstep + cur.ks * ksl; const char* cB = (const char*)g.Bt + (size_t)cur.pn * tstep + cur.ks * ksl;
    PG8_STAGE(PG8_SB(0, 0), cB, voffB); PG8_STAGE(PG8_SA(0, 0), cA, voffA); PG8_STAGE(PG8_SB(0, 1), cB + hstep, voffB); PG8_STAGE(PG8_SA(0, 1), cA + hstep, voffA);
    if (wr == 1) PG8_BAR;
    PG8_WAIT_V(4); PG8_BAR;
    PG8_STAGE(PG8_SB(1, 0), cB + kstep, voffB); PG8_STAGE(PG8_SA(1, 0), cA + kstep, voffA); PG8_STAGE(PG8_SB(1, 1), cB + hstep + kstep, voffB);
    PG8_WAIT_V(6); PG8_BAR;
    for (;;) {
        const bool has_next = S.next(ui + 1, nxt);
        const char* nA = has_next ? (const char*)g.A + (size_t)nxt.pm * tstep + nxt.ks * ksl : cA; const char* nB = has_next ? (const char*)g.Bt + (size_t)nxt.pn * tstep + nxt.ks * ksl : cB;
        for (int t = 0; t < nt; t += 2) {
            const bool last = (t == nt - 2);
            const char* a1 = cA + (size_t)(t + 1) * kstep;
            const char* a2 = last ? nA : cA + (size_t)(t + 2) * kstep; const char* b2 = last ? nB : cB + (size_t)(t + 2) * kstep;
            const char* a3 = a2 + kstep; const char* b3 = b2 + kstep;
            if constexpr (Epi::RESCALE) { if (t == 8 || t == 16) E.rescale(acc, cur, wr, wc, fr, fq, t == 8 ? 0 : 1); }
            PG8_LDB(B0, 0, 0); PG8_SCHED; PG8_LDA(At, 0, 0); PG8_STAGE(PG8_SA(1, 1), a1 + hstep, voffA);
            PG8_WAIT_L(8); PG8_BAR; PG8_WAIT_L(0); PG8_MMA(0, 0, At, B0); PG8_BAR; PG8_SCHED;
            PG8_LDB(B1, 0, 1); PG8_STAGE(PG8_SB(0, 0), b2, voffB);
            PG8_BAR; PG8_WAIT_L(0); PG8_MMA(0, 1, At, B1); PG8_BAR;
            PG8_LDA(At, 0, 1); PG8_STAGE(PG8_SA(0, 0), a2, voffA);
            PG8_BAR; PG8_WAIT_L(0); PG8_MMA(1, 0, At, B0); PG8_BAR; PG8_SCHED;
            PG8_STAGE(PG8_SB(0, 1), b2 + hstep, voffB);
            PG8_WAIT_V(6); PG8_BAR; PG8_MMA(1, 1, At, B1); PG8_BAR;
            PG8_LDB(B0, 1, 0); PG8_SCHED; PG8_LDA(At, 1, 0); PG8_STAGE(PG8_SA(0, 1), a2 + hstep, voffA);
            PG8_WAIT_L(8); PG8_BAR; PG8_WAIT_L(0); PG8_MMA(0, 0, At, B0); PG8_BAR; PG8_SCHED;
            PG8_LDB(B1, 1, 1); PG8_STAGE(PG8_SB(1, 0), b3, voffB);
            PG8_BAR; PG8_WAIT_L(0); PG8_MMA(0, 1, At, B1); PG8_BAR;
            PG8_LDA(At, 1, 1); PG8_STAGE(PG8_SA(1, 0), a3, voffA);
            PG8_BAR; PG8_WAIT_L(0); PG8_MMA(1, 0, At, B0); PG8_BAR; PG8_SCHED;
            PG8_STAGE(PG8_SB(1, 1), b3 + hstep, voffB);
            PG8_WAIT_V(6); PG8_BAR; PG8_MMA(1, 1, At, B1); PG8_BAR;
        }
        E(acc, cur, wr, wc, fr, fq);
        if (!has_next) break;
#pragma unroll
        for (int a = 0; a < 2; ++a)
#pragma unroll
            for (int b = 0; b < 2; ++b)
#pragma unroll
                for (int m = 0; m < 4; ++m)
#pragma unroll
                    for (int n = 0; n < 2; ++n) acc[a][b][m][n] = (f32x4){0.f, 0.f, 0.f, 0.f};
        cur = nxt; cA = nA; cB = nB; ++ui;
    }
    PG8_WAIT_V(0);
    if (wr == 0) PG8_BAR;
    PG8_BAR;
#undef PG8_SA
#undef PG8_SB
#undef PG8_STAGE
#undef PG8_LDA
#undef PG8_LDB
#undef PG8_MMA
#undef PG8_WAIT_V
#undef PG8_WAIT_L
#undef PG8_BAR
#undef PG8_SCHED
}
}
using pg8::Unit; using pg8::HALF; using pg8::BM; using pg8::cvt_pk_bf16;

struct EpiMain {
    static constexpr bool PERM = false, RESCALE = false;
    unsigned char* ws;
    __device__ __forceinline__ void operator()(const f32x4 (&acc)[2][2][4][2], const Unit& u, int wr, int wc, int fr, int fq) const {
        const int row0 = u.pm * BM + wr * 64 + fr;
        if (u.pn < 8) {
            bf16_t* base; int ld, colt;
            if (u.pn < 6) { base = (bf16_t*)(ws + A_QKV); ld = 1536; colt = u.pn * BM; } else { base = (bf16_t*)(ws + A_Z); ld = 512; colt = (u.pn - 6) * BM; }
            const int col0 = colt + wc * 32 + 4 * fq;
#pragma unroll
            for (int ai = 0; ai < 2; ++ai)
#pragma unroll
                for (int m = 0; m < 4; ++m) { bf16_t* rowp = base + (size_t)(row0 + ai * HALF + m * 16) * ld + col0;
#pragma unroll
                    for (int bj = 0; bj < 2; ++bj)
#pragma unroll
                        for (int n = 0; n < 2; ++n) { const f32x4 v = acc[ai][bj][m][n]; u32x2 w; w.x = cvt_pk_bf16(v[0], v[1]); w.y = cvt_pk_bf16(v[2], v[3]); *(u32x2*)(rowp + bj * HALF + n * 16) = w; } }
        } else if (u.pn == 12) {
            if (wc == 0) { float* ba = (float*)(ws + WS_BA);
#pragma unroll
                for (int ai = 0; ai < 2; ++ai)
#pragma unroll
                    for (int m = 0; m < 4; ++m) *(f32x4*)(ba + (size_t)(row0 + ai * HALF + m * 16) * 16 + 4 * fq) = acc[ai][0][m][0]; }
        } else {
            const int chb = (u.pn - 8) * BM + wc * 32 + 4 * fq;
            int b, t0, nlen; bf16_t* fbase; bf16_t* hbase;
            if (u.pm < 64) { b = u.pm >> 5; t0 = (u.pm & 31) * BM + wr * 64 + fr; nlen = SEQ; fbase = (bf16_t*)(ws + A_FNT); hbase = (bf16_t*)(ws + A_HYT); }
            else { b = u.pm - 64; t0 = wr * 64 + fr; nlen = CTXL; fbase = (bf16_t*)(ws + A_FNTC); hbase = (bf16_t*)(ws + A_HYTC); }
#pragma unroll
            for (int bj = 0; bj < 2; ++bj)
#pragma unroll
                for (int n = 0; n < 2; ++n)
#pragma unroll
                    for (int j = 0; j < 4; ++j) { const int ch = chb + bj * HALF + n * 16 + j;
                        bf16_t* p = (ch < 256) ? fbase + ((size_t)(b * 256 + ch)) * nlen : hbase + ((size_t)(b * 768 + ch - 256)) * nlen;
#pragma unroll
                        for (int ai = 0; ai < 2; ++ai)
#pragma unroll
                            for (int m = 0; m < 4; ++m) p[t0 + ai * HALF + m * 16] = f2bf(acc[ai][bj][m][n][j]); }
        }
    }
};
struct EpiGate {
    static constexpr bool PERM = true, RESCALE = false;
    bf16_t* O;
    __device__ __forceinline__ void operator()(const f32x4 (&acc)[2][2][4][2], const Unit& u, int wr, int wc, int fr, int fq) const {
        const int row0 = u.pm * BM + wr * 64 + fr, col0 = u.pn * BM + wc * 32 + 8 * fq;
#pragma unroll
        for (int ai = 0; ai < 2; ++ai)
#pragma unroll
            for (int m = 0; m < 4; ++m) { bf16_t* rowp = O + (size_t)(row0 + ai * HALF + m * 16) * 3072 + col0;
#pragma unroll
                for (int bj = 0; bj < 2; ++bj) { f32x4 v0 = acc[ai][bj][m][0], v1 = acc[ai][bj][m][1];
#pragma unroll
                    for (int j = 0; j < 4; ++j) { v0[j] = sigmoidf(v0[j]); v1[j] = sigmoidf(v1[j]); }
                    u32x4 w; w.x = cvt_pk_bf16(v0[0], v0[1]); w.y = cvt_pk_bf16(v0[2], v0[3]); w.z = cvt_pk_bf16(v1[0], v1[1]); w.w = cvt_pk_bf16(v1[2], v1[3]);
                    *(u32x4*)(rowp + bj * HALF) = w; } }
    }
};
struct EpiRelu2 {
    static constexpr bool PERM = true, RESCALE = false;
    bf16_t* O;
    __device__ __forceinline__ void operator()(const f32x4 (&acc)[2][2][4][2], const Unit& u, int wr, int wc, int fr, int fq) const {
        const int row0 = u.pm * BM + wr * 64 + fr, col0 = u.pn * BM + wc * 32 + 8 * fq;
#pragma unroll
        for (int ai = 0; ai < 2; ++ai)
#pragma unroll
            for (int m = 0; m < 4; ++m) { bf16_t* rowp = O + (size_t)(row0 + ai * HALF + m * 16) * DFF + col0;
#pragma unroll
                for (int bj = 0; bj < 2; ++bj) { f32x4 v0 = acc[ai][bj][m][0], v1 = acc[ai][bj][m][1];
#pragma unroll
                    for (int j = 0; j < 4; ++j) { const float a = fmaxf(v0[j], 0.f), b = fmaxf(v1[j], 0.f); v0[j] = a * a; v1[j] = b * b; }
                    u32x4 w; w.x = cvt_pk_bf16(v0[0], v0[1]); w.y = cvt_pk_bf16(v0[2], v0[3]); w.z = cvt_pk_bf16(v1[0], v1[1]); w.w = cvt_pk_bf16(v1[2], v1[3]);
                    *(u32x4*)(rowp + bj * HALF) = w; } }
    }
};
struct EpiMerge {
    static constexpr bool PERM = true, RESCALE = true;
    const bf16_t* G; bf16_t* O;
    __device__ __forceinline__ void rescale(f32x4 (&acc)[2][2][4][2], const Unit& u, int wr, int wc, int fr, int fq, int seg) const {
        const int row0 = u.pm * BM + wr * 64 + fr, col0 = u.pn * BM + wc * 32 + 8 * fq;
        const bf16_t* gbase = G + (size_t)row0 * 3072 + seg * 1024 + col0;
#pragma unroll
        for (int ai = 0; ai < 2; ++ai)
#pragma unroll
            for (int mp = 0; mp < 2; ++mp) {
                u32x4 gn[2][2], gd[2][2];
#pragma unroll
                for (int mm = 0; mm < 2; ++mm)
#pragma unroll
                    for (int bj = 0; bj < 2; ++bj) { const bf16_t* gp = gbase + (size_t)(ai * HALF + (mp * 2 + mm) * 16) * 3072 + bj * HALF; gn[mm][bj] = *(const u32x4*)gp; gd[mm][bj] = *(const u32x4*)(gp + 1024); }
#pragma unroll
                for (int mm = 0; mm < 2; ++mm)
#pragma unroll
                    for (int bj = 0; bj < 2; ++bj) { const int m = mp * 2 + mm; const u32x4 n_ = gn[mm][bj], d_ = gd[mm][bj];
                        f32x4 v0 = acc[ai][bj][m][0], v1 = acc[ai][bj][m][1];
                        v0[0] *= lo2f(n_.x) * __builtin_amdgcn_rcpf(lo2f(d_.x)); v0[1] *= hi2f(n_.x) * __builtin_amdgcn_rcpf(hi2f(d_.x));
                        v0[2] *= lo2f(n_.y) * __builtin_amdgcn_rcpf(lo2f(d_.y)); v0[3] *= hi2f(n_.y) * __builtin_amdgcn_rcpf(hi2f(d_.y));
                        v1[0] *= lo2f(n_.z) * __builtin_amdgcn_rcpf(lo2f(d_.z)); v1[1] *= hi2f(n_.z) * __builtin_amdgcn_rcpf(hi2f(d_.z));
                        v1[2] *= lo2f(n_.w) * __builtin_amdgcn_rcpf(lo2f(d_.w)); v1[3] *= hi2f(n_.w) * __builtin_amdgcn_rcpf(hi2f(d_.w));
                        acc[ai][bj][m][0] = v0; acc[ai][bj][m][1] = v1; }
                asm volatile("" ::: "memory"); }
        __builtin_amdgcn_sched_barrier(0);
    }
    __device__ __forceinline__ void operator()(const f32x4 (&acc)[2][2][4][2], const Unit& u, int wr, int wc, int fr, int fq) const {
        const int row0 = u.pm * BM + wr * 64 + fr, col0 = u.pn * BM + wc * 32 + 8 * fq;
#pragma unroll
        for (int ai = 0; ai < 2; ++ai)
#pragma unroll
            for (int m = 0; m < 4; ++m) { const size_t r = (size_t)(row0 + ai * HALF + m * 16);
#pragma unroll
                for (int bj = 0; bj < 2; ++bj) { const u32x4 g2 = *(const u32x4*)(G + r * 3072 + 2048 + col0 + bj * HALF);
                    const f32x4 v0 = acc[ai][bj][m][0], v1 = acc[ai][bj][m][1];
                    u32x4 w; w.x = cvt_pk_bf16(v0[0] * lo2f(g2.x), v0[1] * hi2f(g2.x)); w.y = cvt_pk_bf16(v0[2] * lo2f(g2.y), v0[3] * hi2f(g2.y));
                    w.z = cvt_pk_bf16(v1[0] * lo2f(g2.z), v1[1] * hi2f(g2.z)); w.w = cvt_pk_bf16(v1[2] * lo2f(g2.w), v1[3] * hi2f(g2.w));
                    *(u32x4*)(O + r * 1024 + col0 + bj * HALF) = w; } }
    }
};
struct EpiRes {
    static constexpr bool PERM = false, RESCALE = false;
    const float* base_lat; const float* base_ctx; float* out_lat; float* out_ctx; const float* mod;
    __device__ __forceinline__ void operator()(const f32x4 (&acc)[2][2][4][2], const Unit& u, int wr, int wc, int fr, int fq) const {
        const int col0 = u.pn * BM + wc * 32 + 4 * fq;
        const float* bs; float* os; int v, rloc;
        if (u.pm < 64) { bs = base_lat; os = out_lat; v = u.pm >> 5; rloc = u.pm * BM; } else { bs = base_ctx; os = out_ctx; v = 2; rloc = (u.pm - 64) * BM; }
        const int row0 = rloc + wr * 64 + fr;
        f32x4 mv[2][2];
#pragma unroll
        for (int bj = 0; bj < 2; ++bj)
#pragma unroll
            for (int n = 0; n < 2; ++n) mv[bj][n] = *(const f32x4*)(mod + v * 6144 + col0 + bj * HALF + n * 16);
#pragma unroll
        for (int ai = 0; ai < 2; ++ai)
#pragma unroll
            for (int m = 0; m < 4; ++m) { const size_t off = (size_t)(row0 + ai * HALF + m * 16) * D + col0;
#pragma unroll
                for (int bj = 0; bj < 2; ++bj)
#pragma unroll
                    for (int n = 0; n < 2; ++n) { const f32x4 b = *(const f32x4*)(bs + off + bj * HALF + n * 16); *(f32x4*)(os + off + bj * HALF + n * 16) = b + mv[bj][n] * acc[ai][bj][m][n]; }
                if (m & 1) asm volatile("" ::: "memory"); }
    }
};

struct EpiPart {
    static constexpr bool PERM = false, RESCALE = false;
    float* part;
    __device__ __forceinline__ void operator()(const f32x4 (&acc)[2][2][4][2], const Unit& u, int wr, int wc, int fr, int fq) const {
        const int col0 = u.pn * BM + wc * 32 + 4 * fq; const int row0 = (u.pm - 64) * BM + wr * 64 + fr;
        float* base = part + (size_t)u.ks * 512 * D;
#pragma unroll
        for (int ai = 0; ai < 2; ++ai)
#pragma unroll
            for (int m = 0; m < 4; ++m) { float* rowp = base + (size_t)(row0 + ai * HALF + m * 16) * D + col0;
#pragma unroll
                for (int bj = 0; bj < 2; ++bj)
#pragma unroll
                    for (int n = 0; n < 2; ++n) *(f32x4*)(rowp + bj * HALF + n * 16) = acc[ai][bj][m][n]; }
    }
};

__device__ __forceinline__ void tr_tile(const float* src, int ld_src, bf16_t* dst, int ld_dst, LAS float* t, int tid) {
#pragma unroll
    for (int i = 0; i < 8; ++i) { const int k = (tid >> 6) + 8 * i, n = tid & 63; t[k * 65 + n] = src[(size_t)k * ld_src + n]; }
    __syncthreads();
    { const int n = tid >> 3, ks = (tid & 7) * 8; u32x4 w;
      w.x = pk2(t[(ks + 0) * 65 + n], t[(ks + 1) * 65 + n]); w.y = pk2(t[(ks + 2) * 65 + n], t[(ks + 3) * 65 + n]);
      w.z = pk2(t[(ks + 4) * 65 + n], t[(ks + 5) * 65 + n]); w.w = pk2(t[(ks + 6) * 65 + n], t[(ks + 7) * 65 + n]);
      *(u32x4*)(dst + (size_t)n * ld_dst + ks) = w; }
    __syncthreads();
}
constexpr int NCONV_A = 1536 + 128 + 64 + 256 + 128 + 4;
__device__ __forceinline__ void conv_item_A(KP P, int l, int it, LAS unsigned char* lds, int tid) {
    LAS float* t = (LAS float*)lds; unsigned char* ws = P->ws;
    if (it < 1536) { const int kt = it & 15, ntile = it >> 4, n0 = ntile * 64, sc = n0 < 2048 ? n0 : n0 + 16;
        tr_tile(P->in[I_WIN] + (size_t)l * D * INW + (size_t)(kt * 64) * INW + sc, INW, (bf16_t*)(ws + WS_WIN) + (size_t)(n0 < 3072 ? n0 : n0 + 256) * D + kt * 64, D, t, tid); return; }
    it -= 1536;
    if (it < 128) { const int kt = it & 7, ntile = it >> 3;
        tr_tile(P->in[I_WA] + (size_t)l * 512 * D + (size_t)(kt * 64) * D + ntile * 64, D, (bf16_t*)(ws + WS_WABC) + (size_t)(ntile * 64) * 1280 + kt * 64, 1280, t, tid); return; }
    it -= 128;
    if (it < 64) { const int kt = it & 3, ntile = it >> 2;
        tr_tile(P->in[I_WC] + (size_t)l * 256 * D + (size_t)(kt * 64) * D + ntile * 64, D, (bf16_t*)(ws + WS_WABC) + (size_t)(ntile * 64) * 1280 + 1024 + kt * 64, 1280, t, tid); return; }
    it -= 64;
    if (it < 256) { const int kt = it & 15, ntile = it >> 4;
        tr_tile(P->in[I_WOUT] + (size_t)l * D * D + (size_t)(kt * 64) * D + ntile * 64, D, (bf16_t*)(ws + WS_WOUT) + (size_t)(ntile * 64) * D + kt * 64, D, t, tid); return; }
    it -= 256;
    if (it < 128) {
        const int ntile = it & 15, g = (it >> 4) & 3, part = it >> 6;
        const float* src = P->in[I_WB] + (size_t)l * 256 * D + (size_t)(g * 64) * D + ntile * 64;
        LAS float* tr = t + 64 * 65;
#pragma unroll
        for (int i = 0; i < 8; ++i) { const int k = (tid >> 6) + 8 * i, n = tid & 63; t[k * 65 + n] = src[(size_t)k * D + n]; }
        if (tid < 64) { float s, c; sincospif((float)tid / 32.0f, &s, &c); tr[tid] = part ? s : c; }
        __syncthreads();
        { const int n = tid >> 3, cs = (tid & 7) * 8; float o[8];
#pragma unroll
          for (int jj = 0; jj < 8; ++jj) o[jj] = 0.f;
#pragma unroll 2
          for (int m = 0; m < 64; ++m) { const float tv = t[m * 65 + n];
#pragma unroll
              for (int jj = 0; jj < 8; ++jj) o[jj] += tr[(m * (cs + jj)) & 63] * tv; }
          u32x4 w; w.x = pk2(o[0], o[1]); w.y = pk2(o[2], o[3]); w.z = pk2(o[4], o[5]); w.w = pk2(o[6], o[7]);
          *(u32x4*)((bf16_t*)(ws + WS_WABC) + (size_t)(ntile * 64 + n) * 1280 + 512 + part * 256 + g * 64 + cs) = w; }
        __syncthreads(); return; }
    it -= 128;
    { bf16_t* dst = (bf16_t*)(ws + WS_WIN) + (size_t)(3072 + it * 64) * D;
      for (int i = 0; i < 16; ++i) { const int idx = i * 512 + tid; const int r = idx >> 7, k0 = (idx & 127) * 8; u32x4 w = (u32x4){0u, 0u, 0u, 0u};
          if (it == 0 && r < 16) { const float* sp = P->in[I_WIN] + (size_t)l * D * INW + (size_t)k0 * INW + 2048 + r;
              w.x = pk2(sp[0], sp[INW]); w.y = pk2(sp[2 * INW], sp[3 * INW]); w.z = pk2(sp[4 * INW], sp[5 * INW]); w.w = pk2(sp[6 * INW], sp[7 * INW]); }
          *(u32x4*)(dst + (size_t)r * D + k0) = w; } }
}
constexpr int NCONV_A_EARLY = 768 + 4, NCONV_A_LATE = NCONV_A - NCONV_A_EARLY;
__device__ __forceinline__ int conv_a_early(int j) { return j < 768 ? j : 2112 + (j - 768); }
__device__ __forceinline__ int conv_a_late(int j) { return 768 + j; }
constexpr int NCONV_F = 2048;
__device__ __forceinline__ void conv_item_F(KP P, int l, int it, LAS unsigned char* lds, int tid) {
    LAS float* t = (LAS float*)lds; unsigned char* ws = P->ws;
    if (it < 1024) { const int kt = it & 15, ntile = it >> 4;
        tr_tile(P->in[I_FF1] + (size_t)l * D * DFF + (size_t)(kt * 64) * DFF + ntile * 64, DFF, (bf16_t*)(ws + A_WF1) + (size_t)(ntile * 64) * D + kt * 64, D, t, tid); return; }
    it -= 1024;
    { const int kt = it & 63, ntile = it >> 6;
      tr_tile(P->in[I_FF2] + (size_t)l * DFF * D + (size_t)(kt * 64) * D + ntile * 64, D, (bf16_t*)(ws + A_WF2) + (size_t)(ntile * 64) * DFF + kt * 64, DFF, t, tid); }
}

__device__ __forceinline__ void modp_item(KP P, int it, int tid) {
    const int kc = it & 15, nb = (it >> 4) % 12, l = it / 192; const int n = nb * 512 + tid;
    const float* w = P->in[I_WMOD] + (size_t)l * D * 6144 + (size_t)(kc * 64) * 6144 + n;
    float a0 = 0.f, a1 = 0.f, a2 = 0.f;
#pragma unroll 8
    for (int k = 0; k < 64; ++k) { const int kk = kc * 64 + k; const float wv = w[(size_t)k * 6144];
        a0 += siluf(P->in[I_C][kk]) * wv; a1 += siluf(P->in[I_C][D + kk]) * wv; a2 += siluf(P->in[I_CCTX][kk]) * wv; }
    float* o = (float*)(P->ws + WS_MODP) + ((size_t)(kc * 2 + l) * 3) * 6144 + n;
    o[0] = a0; o[6144] = a1; o[2 * 6144] = a2;
}
__device__ __forceinline__ void hid2_item(KP P, int it, LAS unsigned char* lds, int tid) {
    int l, n, p0; float* dst;
    if (it < 256) { l = it >> 7; n = SEQ; p0 = (it & 127) * 64; dst = (float*)(P->ws + WS_HID2) + ((size_t)l * SEQ + p0) * 64; }
    else { l = 0; n = CTXL; p0 = (it - 256) * 64; dst = (float*)(P->ws + WS_HID2C) + (size_t)p0 * 64; }
    LAS float* feats = (LAS float*)lds; LAS float* h1 = feats + 64 * 33;
    for (int idx = tid; idx < 64 * 33; idx += NT) { const int p = idx / 33, f = idx % 33; const float pos = (float)(p0 + p); float v;
        if (f == 0) v = pos / (float)(n - 1);
        else { const int bi = (f - 1) & 15; const float band = 1e-4f + (15.0f - 1e-4f) * (float)bi / 15.0f; const float ang = (6.283185307179586f / (float)n) * pos * band; v = (f <= 16) ? cosf(ang) : -sinf(ang); }
        feats[idx] = v; }
    __syncthreads();
    const int p = tid >> 3, og = (tid & 7) * 8;
    { const float* w1 = P->in[I_HW1] + (size_t)l * 33 * 64; float a[8];
#pragma unroll
      for (int j = 0; j < 8; ++j) a[j] = P->in[I_HB1][l * 64 + og + j];
#pragma unroll 11
      for (int f = 0; f < 33; ++f) { const float x = feats[p * 33 + f];
#pragma unroll
          for (int j = 0; j < 8; ++j) a[j] += x * w1[f * 64 + og + j]; }
#pragma unroll
      for (int j = 0; j < 8; ++j) h1[p * 64 + og + j] = sinf(P->in[I_HF1][l * 64 + og + j] * a[j]); }
    __syncthreads();
    { const float* w2 = P->in[I_HW2] + (size_t)l * 64 * 64; float a[8];
#pragma unroll
      for (int j = 0; j < 8; ++j) a[j] = P->in[I_HB2][l * 64 + og + j];
#pragma unroll 8
      for (int f = 0; f < 64; ++f) { const float x = h1[p * 64 + f];
#pragma unroll
          for (int j = 0; j < 8; ++j) a[j] += x * w2[f * 64 + og + j]; }
#pragma unroll
      for (int j = 0; j < 8; ++j) dst[(size_t)p * 64 + og + j] = sinf(P->in[I_HF2][l * 64 + og + j] * a[j]); }
    __syncthreads();
}


__device__ __forceinline__ void filt_item(KP P, int l, int it, bool ctx, LAS unsigned char* lds, int tid) {
    const int n = ctx ? CTXL : SEQ; const int ntt = n / 64; const int tt = it % ntt, ct = it / ntt;
    const float* hid = ctx ? (const float*)(P->ws + WS_HID2C) : (const float*)(P->ws + WS_HID2) + (size_t)l * SEQ * 64;
    float* dst = (float*)(P->ws + (ctx ? A_FILTC : A_FILT));
    LAS float* hs = (LAS float*)lds; LAS float* wsm = hs + 64 * 64;
    __syncthreads();
#pragma unroll
    for (int i = 0; i < 8; ++i) { const int r = (tid >> 6) + 8 * i, c = tid & 63;
        hs[r * 64 + c] = hid[(size_t)(tt * 64 + r) * 64 + c];
        wsm[r * 65 + c] = P->in[I_HW3][(size_t)l * 64 * 1024 + (size_t)r * 1024 + ct * 64 + c]; }
    __syncthreads();
    { const int col = tid & 63, ts = (tid >> 6) * 8; float o[8];
#pragma unroll
      for (int jj = 0; jj < 8; ++jj) o[jj] = 0.f;
#pragma unroll 2
      for (int j4 = 0; j4 < 16; ++j4) { const float w0 = wsm[(4 * j4) * 65 + col], w1 = wsm[(4 * j4 + 1) * 65 + col], w2 = wsm[(4 * j4 + 2) * 65 + col], w3 = wsm[(4 * j4 + 3) * 65 + col];
#pragma unroll
          for (int jj = 0; jj < 8; ++jj) { const f32x4 h4 = *(const LAS f32x4*)(hs + (ts + jj) * 64 + 4 * j4); o[jj] += h4[0] * w0 + h4[1] * w1 + h4[2] * w2 + h4[3] * w3; } }
      float* op = dst + (size_t)(ct * 64 + col) * n + tt * 64 + ts;
      *(f32x4*)op = (f32x4){o[0], o[1], o[2], o[3]}; *(f32x4*)(op + 4) = (f32x4){o[4], o[5], o[6], o[7]}; }
}

__device__ __forceinline__ const float* hrow(KP P, int r, bool from_input) {
    if (r < NLAT) return (from_input ? P->in[I_X] : P->out) + (size_t)r * D;
    return (from_input ? P->in[I_CTX] : (const float*)(P->ws + WS_HC)) + (size_t)(r - NLAT) * D;
}
__device__ __forceinline__ void modulate_rows(KP P, int l, int which, bool from_input, int nrows, bool do_ba, int gwave, int nwaves, int lane) {
    const float* gain = P->in[which ? I_NORM2 : I_NORM1] + l * D;
    const float* mod = (const float*)(P->ws + WS_MOD) + (size_t)l * 3 * 6144;
    bf16_t* XN = (bf16_t*)(P->ws + A_XN);
    f32x4 g[4];
#pragma unroll
    for (int i = 0; i < 4; ++i) g[i] = *(const f32x4*)(gain + i * 256 + lane * 4);
    for (int r0 = gwave; r0 < nrows; r0 += 2 * nwaves) {
        const int r1 = r0 + nwaves; const bool has1 = r1 < nrows; const int rr1 = has1 ? r1 : r0;
        const float* h0 = hrow(P, r0, from_input); const float* h1 = hrow(P, rr1, from_input);
        f32x4 x0[4], x1[4]; float ss0 = 0.f, ss1 = 0.f;
#pragma unroll
        for (int i = 0; i < 4; ++i) { x0[i] = *(const f32x4*)(h0 + i * 256 + lane * 4); x1[i] = *(const f32x4*)(h1 + i * 256 + lane * 4); }
#pragma unroll
        for (int i = 0; i < 4; ++i) { ss0 += x0[i][0] * x0[i][0] + x0[i][1] * x0[i][1] + x0[i][2] * x0[i][2] + x0[i][3] * x0[i][3];
                                      ss1 += x1[i][0] * x1[i][0] + x1[i][1] * x1[i][1] + x1[i][2] * x1[i][2] + x1[i][3] * x1[i][3]; }
        for (int o = 32; o >= 1; o >>= 1) { ss0 += __shfl_xor(ss0, o); ss1 += __shfl_xor(ss1, o); }
        const float rs0 = rsqrtf(ss0 * (1.0f / D) + EPS), rs1 = rsqrtf(ss1 * (1.0f / D) + EPS);
        const int v0 = r0 < SEQ ? 0 : (r0 < NLAT ? 1 : 2), v1 = rr1 < SEQ ? 0 : (rr1 < NLAT ? 1 : 2);
        const float* sh0 = mod + v0 * 6144 + (which ? 3 : 0) * D; const float* sh1 = mod + v1 * 6144 + (which ? 3 : 0) * D;
#pragma unroll
        for (int i = 0; i < 4; ++i) { const int c = i * 256 + lane * 4;
            const f32x4 a1 = *(const f32x4*)(sh0 + D + c), a0 = *(const f32x4*)(sh0 + c), b1 = *(const f32x4*)(sh1 + D + c), b0 = *(const f32x4*)(sh1 + c);
#pragma unroll
            for (int j = 0; j < 4; ++j) { x0[i][j] = x0[i][j] * rs0 * g[i][j] * (1.0f + a1[j]) + a0[j]; x1[i][j] = x1[i][j] * rs1 * g[i][j] * (1.0f + b1[j]) + b0[j]; }
            u32x2 w; w.x = pk2(x0[i][0], x0[i][1]); w.y = pk2(x0[i][2], x0[i][3]); *(u32x2*)(XN + (size_t)r0 * D + c) = w;
            if (has1) { u32x2 w2; w2.x = pk2(x1[i][0], x1[i][1]); w2.y = pk2(x1[i][2], x1[i][3]); *(u32x2*)(XN + (size_t)r1 * D + c) = w2; } }
    }
}

template <int LOGN>
__device__ __forceinline__ void fft_lds(LAS f32x2* buf, const f32x2* __restrict__ tw, const bool inv, const int tid) {
    constexpr int N = 1 << LOGN;
    int Ns = 1;
#pragma unroll 1
    for (int p = 0; p < LOGN / 2; ++p) {
        constexpr int T = N / 4, NB = (T + NT - 1) / NT;
        const float rNs4 = 0.25f / (float)Ns;
        f32x2 v[NB][4]; int j0s[NB];
#pragma unroll
        for (int i = 0; i < NB; ++i) { const int j = tid + NT * i;
            if (T >= NT || j < T) {
                const int k = j & (Ns - 1); const float rev = (float)k * rNs4;
                f32x2 a0 = buf[j], a1 = buf[j + T], a2 = buf[j + 2 * T], a3 = buf[j + 3 * T];
                if (Ns != 1) {
                    f32x2 w1 = (f32x2){__builtin_amdgcn_cosf(rev), -__builtin_amdgcn_sinf(rev)};
                    if (inv) w1.y = -w1.y;
                    const f32x2 w2 = cmul(w1, w1), w3 = cmul(w1, w2);
                    a1 = cmul(a1, w1); a2 = cmul(a2, w2); a3 = cmul(a3, w3); }
                const f32x2 t0 = a0 + a2, t1 = a0 - a2, t2 = a1 + a3, d = a1 - a3;
                const f32x2 t3 = inv ? (f32x2){-d.y, d.x} : (f32x2){d.y, -d.x};
                v[i][0] = t0 + t2; v[i][1] = t1 + t3; v[i][2] = t0 - t2; v[i][3] = t1 - t3;
                j0s[i] = ((j - k) << 2) + k;
                if (i & 1) asm volatile("" : "+v"(v[i][0]), "+v"(v[i][1]), "+v"(v[i][2]), "+v"(v[i][3]) :: "memory"); } }
        __syncthreads();
#pragma unroll
        for (int i = 0; i < NB; ++i) { const int j = tid + NT * i;
            if (T >= NT || j < T) {
                if (Ns == 1) {
                    *(LAS f32x4*)(buf + j0s[i]) = (f32x4){v[i][0].x, v[i][0].y, v[i][1].x, v[i][1].y};
                    *(LAS f32x4*)(buf + j0s[i] + 2) = (f32x4){v[i][2].x, v[i][2].y, v[i][3].x, v[i][3].y};
                } else { buf[j0s[i]] = v[i][0]; buf[j0s[i] + Ns] = v[i][1]; buf[j0s[i] + 2 * Ns] = v[i][2]; buf[j0s[i] + 3 * Ns] = v[i][3]; } } }
        __syncthreads();
        Ns <<= 2;
    }
    if (LOGN & 1) {
        constexpr int T = N / 2, NB = (T + NT - 1) / NT;
        f32x2 v[NB][2]; int j0s[NB];
#pragma unroll
        for (int i = 0; i < NB; ++i) { const int j = tid + NT * i;
            if (T >= NT || j < T) {
                const int k = j & (Ns - 1); const float rev = (float)k * (0.5f / (float)Ns);
                f32x2 a0 = buf[j], a1 = buf[j + T]; f32x2 w1 = (f32x2){__builtin_amdgcn_cosf(rev), -__builtin_amdgcn_sinf(rev)}; if (inv) w1.y = -w1.y;
                a1 = cmul(a1, w1); v[i][0] = a0 + a1; v[i][1] = a0 - a1; j0s[i] = ((j - k) << 1) + k; } }
        __syncthreads();
#pragma unroll
        for (int i = 0; i < NB; ++i) { const int j = tid + NT * i; if (T >= NT || j < T) { buf[j0s[i]] = v[i][0]; buf[j0s[i] + Ns] = v[i][1]; } }
        __syncthreads();
    }
}

__device__ __forceinline__ float sconv(const bf16_t* p, int t, int n, float w0, float w1, float w2) {
    float a = w1 * bf2f(p[t]); if (t > 0) a += w0 * bf2f(p[t - 1]); if (t + 1 < n) a += w2 * bf2f(p[t + 1]); return a;
}

template <int LOGN2>
__device__ __forceinline__ void hyena_job(KP P, int l, int c, LAS unsigned char* lds, int tid) {
    constexpr int N2 = 1 << LOGN2, n = N2 / 2, NI = (n + NT - 1) / NT;
    LAS f32x2* buf = (LAS f32x2*)lds; LAS float* sm = (LAS float*)(lds + 131072);
    unsigned char* ws = P->ws;
    const f32x2* tw = (const f32x2*)(ws + WS_TW);
    const float* hid = (n == SEQ) ? (const float*)(ws + WS_HID2) + (size_t)l * SEQ * 64 : (const float*)(ws + WS_HID2C);
    f32x2* KF = (f32x2*)(ws + A_KF) + (size_t)blockIdx.x * 2 * KF_STRIDE;
    const bf16_t* hyt = (n == SEQ) ? (const bf16_t*)(ws + A_HYT) : (const bf16_t*)(ws + A_HYTC);
    bf16_t* yct = (n == SEQ) ? (bf16_t*)(ws + A_YCT) : (bf16_t*)(ws + A_YCTC);
    __syncthreads();
    const float* filt = (const float*)(ws + ((n == SEQ) ? A_FILT : A_FILTC));
    const float dmin = -3.0701134573253945f, dmax = -15.350567286626972f;
    const float delta0 = fabsf(dmin + (dmax - dmin) * (float)c / 511.0f), delta1 = fabsf(dmin + (dmax - dmin) * (float)(256 + c) / 511.0f);
    float s0 = 0.f, s1 = 0.f;
#pragma unroll 4
    for (int i = 0; i < NI; ++i) { const int t = tid + NT * i;
        if (n >= NT || t < n) {
            float f00 = filt[(size_t)c * n + t], f01 = filt[(size_t)(256 + c) * n + t], f10 = filt[(size_t)(512 + c) * n + t], f11 = filt[(size_t)(768 + c) * n + t];
            const float tn = (float)t / (float)(n - 1); const float d0 = __expf(-tn * delta0), d1 = __expf(-tn * delta1);
            f00 *= d0; f10 *= d0; f01 *= d1; f11 *= d1;
            buf[t] = (f32x2){f00, f01}; s0 += fabsf(f00); s1 += fabsf(f01);
            if (t >= 1) { buf[N2 - t] = (f32x2){f10, f11}; s0 += fabsf(f10); s1 += fabsf(f11); }
            else buf[n] = (f32x2){0.f, 0.f};
        } }
    s0 = wave_sum(s0); s1 = wave_sum(s1);
    if ((tid & 63) == 0) { sm[256 + (tid >> 6)] = s0; sm[264 + (tid >> 6)] = s1; }
    __syncthreads();
    float t0 = 0.f, t1 = 0.f;
#pragma unroll
    for (int w = 0; w < 8; ++w) { t0 += sm[256 + w]; t1 += sm[264 + w]; }
    const float inv0 = 1.0f / (t0 * (float)N2), inv1 = 1.0f / (t1 * (float)N2);
    fft_lds<LOGN2>(buf, tw, false, tid);
#pragma unroll 4
    for (int i = 0; i < (n + NT) / NT; ++i) { const int k = tid + NT * i;
        if (k <= n) { const f32x2 z = buf[k], w = buf[(N2 - k) & (N2 - 1)];
            KF[k] = (f32x2){0.5f * (z.x + w.x) * inv0, 0.5f * (z.y - w.y) * inv0};
            KF[KF_STRIDE + k] = (f32x2){0.5f * (z.y + w.y) * inv1, -0.5f * (z.x - w.x) * inv1}; } }
    __threadfence_block();
    __syncthreads();
    float zr[NI], zi[NI];
    const float* cw = P->in[I_HYCONV] + (size_t)l * 3 * 768;
    { const int row = 512 + c; const float w0 = cw[row], w1 = cw[768 + row], w2 = cw[1536 + row];
#pragma unroll
      for (int i = 0; i < NI; ++i) { const int t = tid + NT * i; if (n >= NT || t < n) { zr[i] = sconv(hyt + (size_t)row * n, t, n, w0, w1, w2); zi[i] = sconv(hyt + (size_t)(768 + row) * n, t, n, w0, w1, w2); } } }
#pragma unroll 1
    for (int o = 0; o < 2; ++o) {
#pragma unroll
        for (int i = 0; i < NI; ++i) { const int t = tid + NT * i; if (n >= NT || t < n) { buf[t] = (f32x2){zr[i], zi[i]}; buf[t + n] = (f32x2){0.f, 0.f}; } }
        __syncthreads();
        fft_lds<LOGN2>(buf, tw, false, tid);
        const f32x2* Ko = KF + o * KF_STRIDE;
#pragma unroll 4
        for (int i = 0; i < (N2 + NT - 1) / NT; ++i) { const int k = tid + NT * i;
            if (N2 >= NT || k < N2) { f32x2 kk; if (k <= n) kk = Ko[k]; else { kk = Ko[N2 - k]; kk.y = -kk.y; } buf[k] = cmul(buf[k], kk); } }
        __syncthreads();
        fft_lds<LOGN2>(buf, tw, true, tid);
        const int row = o * 256 + c; const float w0 = cw[row], w1 = cw[768 + row], w2 = cw[1536 + row];
        const float bias = P->in[I_HBIAS][l * 512 + o * 256 + c];
#pragma unroll
        for (int i = 0; i < NI; ++i) { const int t = tid + NT * i;
            if (n >= NT || t < n) { const f32x2 cv = buf[t];
                const float x0 = sconv(hyt + (size_t)row * n, t, n, w0, w1, w2), x1 = sconv(hyt + (size_t)(768 + row) * n, t, n, w0, w1, w2);
                zr[i] = x0 * (cv.x + bias * zr[i]); zi[i] = x1 * (cv.y + bias * zi[i]); } }
        __syncthreads();
    }
#pragma unroll
    for (int i = 0; i < NI; ++i) { const int t = tid + NT * i; if (n >= NT || t < n) { yct[(size_t)c * n + t] = f2bf(zr[i]); yct[(size_t)(256 + c) * n + t] = f2bf(zi[i]); } }
}

template <int LOGN>
__device__ __forceinline__ void fnet_job(KP P, int ch, LAS unsigned char* lds, int tid) {
    constexpr int N = 1 << LOGN, NI = (N + NT - 1) / NT;
    LAS f32x2* buf = (LAS f32x2*)lds; unsigned char* ws = P->ws;
    const f32x2* tw = (const f32x2*)(ws + WS_TW);
    const bf16_t* fnt = (N == SEQ) ? (const bf16_t*)(ws + A_FNT) : (const bf16_t*)(ws + A_FNTC);
    bf16_t* ybt = (N == SEQ) ? (bf16_t*)(ws + A_YBT) : (bf16_t*)(ws + A_YBTC);
    const float s = rsqrtf((float)N * 64.0f);
    __syncthreads();
#pragma unroll 4
    for (int i = 0; i < NI; ++i) { const int t = tid + NT * i; if (N >= NT || t < N) buf[t] = (f32x2){bf2f(fnt[(size_t)ch * N + t]), bf2f(fnt[(size_t)(256 + ch) * N + t])}; }
    __syncthreads();
    fft_lds<LOGN>(buf, tw, false, tid);
#pragma unroll 4
    for (int i = 0; i < NI; ++i) { const int k = tid + NT * i;
        if (N >= NT || k < N) { const f32x2 z = buf[k], w = buf[(N - k) & (N - 1)];
            ybt[(size_t)ch * N + k] = f2bf(0.5f * s * (z.x + w.x)); ybt[(size_t)(256 + ch) * N + k] = f2bf(0.5f * s * (z.y - w.y));
            ybt[(size_t)(512 + ch) * N + k] = f2bf(0.5f * s * (z.y + w.y)); ybt[(size_t)(768 + ch) * N + k] = f2bf(-0.5f * s * (z.x - w.x)); } }
    __syncthreads();
}

constexpr int CL_RAW = 0;
constexpr int CL_QS = 50688, CL_KS = CL_QS + 64 * 136 * 2, CL_VS = CL_KS + 64 * 136 * 2;
constexpr int CL_AM = CL_VS + 64 * 136 * 2;
constexpr int CL_GS = CL_AM + 32768;
static_assert(CL_GS + 3 * 512 <= LDS_BYTES, "chunk-local LDS");
template <int DIR, int ISW>
__device__ __forceinline__ void solve_col(unsigned char* ws, LAS unsigned char* lds, size_t it2, int col) {
    asm volatile("" : "+v"(lds));
    const LAS float* AM = (const LAS float*)(lds + CL_AM) + DIR * 4096;
    const LAS float* BS = (const LAS float*)(lds + CL_GS) + 128 + DIR * 64; const LAS float* EG = (const LAS float*)(lds + CL_GS) + 256 + DIR * 64;
    const LAS bf16_t* src = ISW ? (const LAS bf16_t*)(lds + CL_KS) + (col - 128) : (const LAS bf16_t*)(lds + CL_VS) + col;
    float x[64];
#pragma unroll
    for (int i = 0; i < 64; ++i) x[i] = 0.f;
    f32x4 c0, c1, c2, c3;
    { const volatile LAS f32x4* ap = (const volatile LAS f32x4*)AM; c0 = ap[0]; c1 = ap[1]; c2 = ap[2]; c3 = ap[3]; }
#pragma unroll
    for (int i = 0; i < 64; ++i) { const int ri = DIR ? 63 - i : i; float s = bf2f(src[ri * 136]) * BS[i]; if (ISW) s *= EG[i];
        float s1 = 0.f, s2 = 0.f, s3 = 0.f;
#pragma unroll
        for (int jc = 0; jc <= i / 16; ++jc) {
            const int ni = (jc < i / 16) ? i : i + 1, nj = (jc < i / 16) ? jc + 1 : 0;
            f32x4 n0 = c0, n1 = c1, n2 = c2, n3 = c3;
            if (ni < 64) { const volatile LAS f32x4* ap = (const volatile LAS f32x4*)(AM + ni * 64 + nj * 16); n0 = ap[0]; n1 = ap[1]; n2 = ap[2]; n3 = ap[3]; }
#pragma unroll
            for (int jj = 0; jj < 4; ++jj) { s -= c0[jj] * x[jc * 16 + jj]; s1 -= c1[jj] * x[jc * 16 + 4 + jj]; s2 -= c2[jj] * x[jc * 16 + 8 + jj]; s3 -= c3[jj] * x[jc * 16 + 12 + jj]; }
            asm volatile("" : "+v"(s), "+v"(s1), "+v"(s2), "+v"(s3), "+v"(n0), "+v"(n1), "+v"(n2), "+v"(n3) :: "memory");
            c0 = n0; c1 = n1; c2 = n2; c3 = n3; }
        x[i] = (s + s1) + (s2 + s3); }
    if (!ISW) { bf16_t* dut = (bf16_t*)(ws + A_DUT) + (it2 + DIR) * 8192 + col * 4;
#pragma unroll
        for (int i4 = 0; i4 < 16; ++i4) *(u32x2*)(dut + i4 * 512) = (u32x2){pk2(x[i4 * 4], x[i4 * 4 + 1]), pk2(x[i4 * 4 + 2], x[i4 * 4 + 3])}; }
    else { const int kc = col - 128; bf16_t* dw = (bf16_t*)(ws + A_DW) + (it2 + DIR) * 8192 + (((kc >> 5) * 64 + ((kc >> 3) & 3) * 16) * 8 + (kc & 7));
#pragma unroll
        for (int i = 0; i < 64; ++i) dw[((i >> 4) * 256 + (i & 15)) * 8] = f2bf(x[i]); }
}
__device__ __forceinline__ void chunk_item(KP P, int l, int item, LAS unsigned char* lds, int tid) {
    unsigned char* ws = P->ws;
    int b, h, cc, rowbase; bool isctx;
    if (item < 1024) { isctx = false; cc = item & 127; h = (item >> 7) & 3; b = item >> 9; rowbase = b * SEQ + cc * 64; }
    else { isctx = true; const int q = item - 1024; cc = q & 3; h = (q >> 2) & 3; b = q >> 4; rowbase = NLAT + b * CTXL + cc * 64; }
    const bf16_t* QKV = (const bf16_t*)(ws + A_QKV);
    LAS bf16_t* raw = (LAS bf16_t*)(lds + CL_RAW);
    const int lane = tid & 63, wid = tid >> 6;
    __syncthreads();
#pragma unroll 1
    for (int comp = 0; comp < 3; ++comp) {
#pragma unroll 1
        for (int ib = 0; ib < 8; ib += 4) { u32x4 v[4];
#pragma unroll
          for (int i = 0; i < 4; ++i) { const int idx = tid + NT * (ib + i); const int seg = idx & 15, pr = idx >> 4, ky = pr / 66, gx = pr % 66 - 1; int srow = -1;
              if (idx < 3 * 66 * 16) {
                  if (!isctx) { const int gr = cc + ky - 1; if (gr >= 0 && gr < 128 && gx >= 0 && gx < 64) srow = b * SEQ + gr * 64 + gx; }
                  else { const int pos = cc * 64 + gx; if (ky == 1 && pos >= 0 && pos < CTXL) srow = NLAT + b * CTXL + pos; } }
              const u32x4 lv = *(const u32x4*)(QKV + (size_t)(srow >= 0 ? srow : 0) * 1536 + comp * 512 + h * 128 + seg * 8);
              v[i] = srow >= 0 ? lv : (u32x4){0u, 0u, 0u, 0u}; }
#pragma unroll
          for (int i = 0; i < 4; ++i) { const int idx = tid + NT * (ib + i); if (idx < 3 * 66 * 16) *(LAS u32x4*)(raw + (size_t)idx * 8) = v[i]; } }
        __syncthreads();
        { const int tok = tid >> 3, cg8 = tid & 7; float a[16];
#pragma unroll
          for (int j = 0; j < 16; ++j) a[j] = 0.f;
          const float* cw = P->in[I_DNCONV] + (size_t)l * 9 * 1536 + comp * 512 + h * 128 + cg8 * 16;
#pragma unroll
          for (int ky = 0; ky < 3; ++ky)
#pragma unroll
              for (int kx = 0; kx < 3; ++kx) { const LAS bf16_t* rp = raw + (size_t)(ky * 66 + tok + kx) * 128 + cg8 * 16; const float* wp = cw + (ky * 3 + kx) * 1536;
                  const u32x4 r0 = *(const LAS u32x4*)rp, r1 = *(const LAS u32x4*)(rp + 8); const unsigned rr[8] = {r0.x, r0.y, r0.z, r0.w, r1.x, r1.y, r1.z, r1.w};
#pragma unroll
                  for (int j = 0; j < 8; ++j) { a[2 * j] += lo2f(rr[j]) * wp[2 * j]; a[2 * j + 1] += hi2f(rr[j]) * wp[2 * j + 1]; } }
          float ss = 0.f;
#pragma unroll
          for (int j = 0; j < 16; ++j) { a[j] = siluf(a[j]); ss += a[j] * a[j]; }
          float sc = 1.0f;
          if (comp < 2) { ss += __shfl_xor(ss, 1); ss += __shfl_xor(ss, 2); ss += __shfl_xor(ss, 4); sc = rsqrtf(ss + EPS); if (comp == 0) sc *= 0.08838834764831845f; }
          LAS bf16_t* dst = (LAS bf16_t*)(lds + (comp == 0 ? CL_QS : (comp == 1 ? CL_KS : CL_VS))) + tok * 136 + cg8 * 16;
          u32x4 w0, w1; w0.x = pk2(a[0] * sc, a[1] * sc); w0.y = pk2(a[2] * sc, a[3] * sc); w0.z = pk2(a[4] * sc, a[5] * sc); w0.w = pk2(a[6] * sc, a[7] * sc);
          w1.x = pk2(a[8] * sc, a[9] * sc); w1.y = pk2(a[10] * sc, a[11] * sc); w1.z = pk2(a[12] * sc, a[13] * sc); w1.w = pk2(a[14] * sc, a[15] * sc);
          *(LAS u32x4*)dst = w0; *(LAS u32x4*)(dst + 8) = w1; }
        __syncthreads();
    }
    { const int mat = wid >> 2, mt = wid & 3, r16 = lane & 15, q4 = lane >> 4;
      const LAS bf16_t* As = (const LAS bf16_t*)(lds + (mat ? CL_QS : CL_KS)); const LAS bf16_t* Ks = (const LAS bf16_t*)(lds + CL_KS);
      LAS float* outm = (LAS float*)(lds + CL_RAW) + mat * 64 * 65;
      bf16x8 af[4];
#pragma unroll
      for (int ks = 0; ks < 4; ++ks) af[ks] = *(const LAS bf16x8*)(As + (mt * 16 + r16) * 136 + ks * 32 + q4 * 8);
#pragma unroll
      for (int ntile = 0; ntile < 4; ++ntile) { f32x4 acc = (f32x4){0.f, 0.f, 0.f, 0.f};
#pragma unroll
          for (int ks = 0; ks < 4; ++ks) { const bf16x8 bfr = *(const LAS bf16x8*)(Ks + (ntile * 16 + r16) * 136 + ks * 32 + q4 * 8); acc = __builtin_amdgcn_mfma_f32_16x16x32_bf16(af[ks], bfr, acc, 0, 0, 0); }
#pragma unroll
          for (int rg = 0; rg < 4; ++rg) outm[(mt * 16 + q4 * 4 + rg) * 65 + ntile * 16 + r16] = acc[rg]; } }
    LAS float* GS = (LAS float*)(lds + CL_GS); LAS float* BS = GS + 128; LAS float* EG = GS + 256;
    if (tid < 128) { const int dir = tid >> 6, ip = tid & 63, i = dir ? 63 - ip : ip;
        const float* ba = (const float*)(ws + WS_BA) + (size_t)(rowbase + i) * 16;
        const float beta = sigmoidf(ba[dir * 4 + h]); const float av = ba[8 + dir * 4 + h] + P->in[I_DTB][l * 8 + dir * 4 + h];
        const float sp = av > 20.f ? av : log1pf(expf(av));
        float g = -expf(P->in[I_ALOG][l * 8 + dir * 4 + h]) * sp;
        for (int o = 1; o < 64; o <<= 1) { const float tv = __shfl_up(g, o); if (ip >= o) g += tv; }
        GS[tid] = g; BS[tid] = beta; EG[tid] = expf(g); }
    __syncthreads();
    const size_t it2 = (size_t)item * 2;
    { LAS float* KK = (LAS float*)(lds + CL_RAW); LAS float* QKr = KK + 64 * 65; LAS float* AM = (LAS float*)(lds + CL_AM);
      bf16_t* DQK = (bf16_t*)(ws + A_DQK);
      for (int idx = tid; idx < 8192; idx += NT) { const int dir = idx >> 12, ip = (idx >> 6) & 63, jp = idx & 63; const int ri = dir ? 63 - ip : ip, rj = dir ? 63 - jp : jp;
          const float dec = (ip >= jp) ? __expf(GS[dir * 64 + ip] - GS[dir * 64 + jp]) : 0.f;
          AM[idx] = (ip > jp) ? BS[dir * 64 + ip] * KK[ri * 65 + rj] * dec : 0.f;
          DQK[(it2 + dir) * 4096 + ((((ip >> 4) * 2 + (jp >> 5)) * 64 + ((jp >> 3) & 3) * 16 + (ip & 15)) * 8 + (jp & 7))] = f2bf(QKr[ri * 65 + rj] * dec); } }
    __syncthreads();
    { const int dir = tid >> 8, col = tid & 255;
      if (dir == 0) { if (col < 128) solve_col<0, 0>(ws, lds, it2, col); else solve_col<0, 1>(ws, lds, it2, col); }
      else { if (col < 128) solve_col<1, 0>(ws, lds, it2, col); else solve_col<1, 1>(ws, lds, it2, col); } }
    { bf16_t* dq = (bf16_t*)(ws + A_DQ) + (size_t)item * 8192; const LAS bf16_t* QS = (const LAS bf16_t*)(lds + CL_QS);
      for (int idx = tid; idx < 1024; idx += NT) { const int r = idx >> 4, seg = idx & 15; *(u32x4*)(dq + ((((r >> 4) * 4 + (seg >> 2)) * 64 + (seg & 3) * 16 + (r & 15)) * 8)) = *(const LAS u32x4*)(QS + r * 136 + seg * 8); }
      bf16_t* dkt = (bf16_t*)(ws + A_DKT) + (size_t)item * 8192; const LAS bf16_t* KS = (const LAS bf16_t*)(lds + CL_KS);
      { const int kd = tid >> 2, is = (tid & 3) * 16; unsigned w[8];
#pragma unroll
        for (int j = 0; j < 8; ++j) w[j] = (unsigned)KS[(is + 2 * j) * 136 + kd] | ((unsigned)KS[(is + 2 * j + 1) * 136 + kd] << 16);
        const int mtk = kd >> 4, rk = kd & 15, ksk = is >> 5, q0 = (is >> 3) & 3;
        *(u32x4*)(dkt + (((mtk * 2 + ksk) * 64 + q0 * 16 + rk) * 8)) = (u32x4){w[0], w[1], w[2], w[3]}; *(u32x4*)(dkt + (((mtk * 2 + ksk) * 64 + (q0 + 1) * 16 + rk) * 8)) = (u32x4){w[4], w[5], w[6], w[7]}; }
      if (tid < 128) ((float*)(ws + WS_DG))[it2 * 64 + tid] = GS[tid]; }
    __syncthreads();
}

struct ScanOps { bf16x8 fa[4]; bf16x8 fb[2]; bf16x8 fc[2]; u32x2 ut; f32x4 g; float glast; };
struct ScanOff { unsigned a, u, b, c, g; };
__device__ __forceinline__ void scan_load(unsigned char* ws, ScanOps& o, const ScanOff& f, int step, int bh, int dir, bool lowhalf, int& rowbase_out) {
    int item, rowbase;
    if (step < 4) { const int cc = dir ? 3 - step : step; item = 1024 + bh * 4 + cc; rowbase = NLAT + (bh >> 2) * CTXL + cc * 64; }
    else { const int lc = step - 4, cc = dir ? 127 - lc : lc; item = bh * 128 + cc; rowbase = (bh >> 2) * SEQ + cc * 64; }
    rowbase_out = rowbase;
    const size_t it2 = (size_t)item * 2 + dir;
    const unsigned char* pA = lowhalf ? ws + A_DW + it2 * 16384 : ws + A_DQ + (size_t)item * 16384;
    const unsigned char* pU = ws + A_DUT + it2 * 16384; const unsigned char* pB = ws + A_DQK + it2 * 8192;
    const unsigned char* pC = ws + A_DKT + (size_t)item * 16384; const unsigned char* pG = ws + WS_DG + it2 * 256;
#pragma unroll
    for (int ks = 0; ks < 4; ++ks) o.fa[ks] = *(const bf16x8*)(pA + f.a + ks * 1024);
    if (lowhalf) o.ut = *(const u32x2*)(pU + f.u);
    else {
#pragma unroll
        for (int ks = 0; ks < 2; ++ks) o.fb[ks] = *(const bf16x8*)(pB + f.b + ks * 1024); }
#pragma unroll
    for (int ks = 0; ks < 2; ++ks) o.fc[ks] = *(const bf16x8*)(pC + f.c + ks * 1024);
    o.g = *(const f32x4*)(pG + f.g); o.glast = *(const float*)(pG + 252);
}
__device__ __forceinline__ void phase_scan(KP P, LAS unsigned char* lds, int tid) {
    const int id = blockIdx.x; if (id >= 128) return;
    unsigned char* ws = P->ws;
    const int vs = (id >> 3) & 7, dir = (id >> 6) & 1, bh = id & 7, h = bh & 3;
    const int lane = tid & 63, wid = __builtin_amdgcn_readfirstlane(tid >> 6), r16 = lane & 15, q4 = lane >> 4, w4 = wid & 3;
    const bool lowhalf = wid < 4;
    LAS bf16_t* ST = (LAS bf16_t*)lds;
    LAS bf16_t* UT = ST + 16 * 136;
    LAS bf16_t* U2T = UT + 16 * 72;
    unsigned char* Obuf = ws + (dir ? A_OB : A_OF);
    ScanOff f;
    { const int ip = w4 * 16 + r16, ri = dir ? 63 - ip : ip;
      f.a = lowhalf ? (unsigned)(((w4 * 4) * 64 + q4 * 16 + r16) * 16) : (unsigned)((((ri >> 4) * 4) * 64 + q4 * 16 + (ri & 15)) * 16);
      f.u = (unsigned)((((w4 * 4 + q4) * 128) + vs * 16 + r16) * 8);
      f.b = (unsigned)(((w4 * 2) * 64 + q4 * 16 + r16) * 16);
      f.c = (unsigned)(((wid * 2) * 64 + q4 * 16 + r16) * 16);
      f.g = (unsigned)((w4 * 16 + q4 * 4) * 4); }
    const int ipo = w4 * 16 + q4 * 4; const int tok0 = dir ? 63 - ipo : ipo; const int ostep = dir ? -1024 : 1024;
    const unsigned offO = (unsigned)((tok0 * 512 + h * 128 + vs * 16 + r16) * 2);
    __syncthreads();
    for (int i = tid; i < 16 * 136; i += NT) ST[i] = 0;
    f32x4 Sacc = (f32x4){0.f, 0.f, 0.f, 0.f};
    ScanOps ops[3]; int rbs[3];
    scan_load(ws, ops[0], f, 0, bh, dir, lowhalf, rbs[0]);
    scan_load(ws, ops[1], f, 1, bh, dir, lowhalf, rbs[1]);
    scan_load(ws, ops[2], f, 2, bh, dir, lowhalf, rbs[2]);
#define SCAN_STEP(cur, rowbase, stepn) do { \
        asm volatile("s_waitcnt lgkmcnt(0)" ::: "memory"); __builtin_amdgcn_s_barrier(); asm volatile("" ::: "memory"); \
        f32x4 acc = (f32x4){0.f, 0.f, 0.f, 0.f}; \
        _Pragma("unroll") for (int ks = 0; ks < 4; ++ks) { const bf16x8 sf = *(const LAS bf16x8*)(ST + r16 * 136 + ks * 32 + q4 * 8); acc = __builtin_amdgcn_mfma_f32_16x16x32_bf16(cur.fa[ks], sf, acc, 0, 0, 0); } \
        const float gl = __expf(cur.glast); \
        if (lowhalf) { \
            float u[4], u2[4]; \
            u[0] = lo2f(cur.ut.x) - acc[0]; u[1] = hi2f(cur.ut.x) - acc[1]; u[2] = lo2f(cur.ut.y) - acc[2]; u[3] = hi2f(cur.ut.y) - acc[3]; \
            _Pragma("unroll") for (int rg = 0; rg < 4; ++rg) u2[rg] = u[rg] * __expf(cur.glast - cur.g[rg]); \
            *(LAS u32x2*)(UT + r16 * 72 + ipo) = (u32x2){pk2(u[0], u[1]), pk2(u[2], u[3])}; \
            if (!dir) *(LAS u32x2*)(U2T + r16 * 72 + ipo) = (u32x2){pk2(u2[0], u2[1]), pk2(u2[2], u2[3])}; \
            else *(LAS u32x2*)(U2T + r16 * 72 + 60 - ipo) = (u32x2){pk2(u2[3], u2[2]), pk2(u2[1], u2[0])}; \
        } else { \
            _Pragma("unroll") for (int rg = 0; rg < 4; ++rg) acc[rg] *= __expf(cur.g[rg]); \
        } \
        asm volatile("s_waitcnt lgkmcnt(0)" ::: "memory"); __builtin_amdgcn_s_barrier(); asm volatile("" ::: "memory"); \
        if (!lowhalf) { \
            _Pragma("unroll") for (int ks = 0; ks < 2; ++ks) { const bf16x8 uf = *(const LAS bf16x8*)(UT + r16 * 72 + ks * 32 + q4 * 8); acc = __builtin_amdgcn_mfma_f32_16x16x32_bf16(cur.fb[ks], uf, acc, 0, 0, 0); } \
            unsigned char* op = Obuf + (size_t)rowbase * 1024 + offO; \
            _Pragma("unroll") for (int rg = 0; rg < 4; ++rg) *(bf16_t*)(op + rg * ostep) = f2bf(acc[rg]); \
        } \
        _Pragma("unroll") for (int rg = 0; rg < 4; ++rg) Sacc[rg] *= gl; \
        _Pragma("unroll") for (int ks = 0; ks < 2; ++ks) { const bf16x8 uf = *(const LAS bf16x8*)(U2T + r16 * 72 + ks * 32 + q4 * 8); Sacc = __builtin_amdgcn_mfma_f32_16x16x32_bf16(cur.fc[ks], uf, Sacc, 0, 0, 0); } \
        *(LAS u32x2*)(ST + r16 * 136 + wid * 16 + q4 * 4) = (u32x2){pk2(Sacc[0], Sacc[1]), pk2(Sacc[2], Sacc[3])}; \
        if ((stepn) + 3 < 132) scan_load(ws, cur, f, (stepn) + 3, bh, dir, lowhalf, rowbase); \
    } while (0)
#pragma unroll 1
    for (int s0 = 0; s0 < 132; s0 += 3) {
        SCAN_STEP(ops[0], rbs[0], s0);
        SCAN_STEP(ops[1], rbs[1], s0 + 1);
        SCAN_STEP(ops[2], rbs[2], s0 + 2);
    }
#undef SCAN_STEP
    __syncthreads();
}

__device__ __forceinline__ void ya_rows(KP P, int l, int nrows, int gwave, int nwaves, int lane) {
    const bf16_t* OF = (const bf16_t*)(P->ws + A_OF); const bf16_t* OB = (const bf16_t*)(P->ws + A_OB); const bf16_t* Z = (const bf16_t*)(P->ws + A_Z);
    bf16_t* Y = (bf16_t*)(P->ws + A_Y); const float* gn = P->in[I_DNON] + l * 128;
    const float g0 = gn[2 * lane], g1 = gn[2 * lane + 1];
    for (int r0 = gwave; r0 < nrows; r0 += 2 * nwaves) {
        const int r1 = r0 + nwaves; const bool has1 = r1 < nrows; const int rr[2] = {r0, has1 ? r1 : r0};
        unsigned a[2][4], bb[2][4], z[2][4];
#pragma unroll
        for (int q = 0; q < 2; ++q)
#pragma unroll
            for (int hh = 0; hh < 4; ++hh) { const size_t off = (size_t)rr[q] * 512 + hh * 128 + 2 * lane; a[q][hh] = *(const unsigned*)(OF + off); bb[q][hh] = *(const unsigned*)(OB + off); z[q][hh] = *(const unsigned*)(Z + off); }
#pragma unroll
        for (int q = 0; q < 2; ++q)
#pragma unroll
            for (int hh = 0; hh < 4; ++hh) {
                const float o0 = lo2f(a[q][hh]) + lo2f(bb[q][hh]), o1 = hi2f(a[q][hh]) + hi2f(bb[q][hh]);
                const float ss = wave_sum(o0 * o0 + o1 * o1); const float rs = rsqrtf(ss * (1.0f / 128.0f) + EPS);
                if (q == 0 || has1) *(unsigned*)(Y + (size_t)rr[q] * 1280 + hh * 128 + 2 * lane) = pk2(o0 * rs * g0 * siluf(lo2f(z[q][hh])), o1 * rs * g1 * siluf(hi2f(z[q][hh]))); }
    }
}
__device__ __forceinline__ void tr_y_item(KP P, int it, bool ctx, LAS unsigned char* lds, int tid) {
    const int ntg = ctx ? 1 : 32; const int tg = it % ntg, ct = (it / ntg) % 12, b = it / (ntg * 12); const int nlen = ctx ? CTXL : SEQ;
    const bf16_t* src; int coloff;
    if (ct < 8) { src = (const bf16_t*)(P->ws + (ctx ? A_YBTC : A_YBT)) + ((size_t)(b * 512 + ct * 64)) * nlen; coloff = 512 + ct * 64; }
    else { src = (const bf16_t*)(P->ws + (ctx ? A_YCTC : A_YCT)) + ((size_t)(b * 256 + (ct - 8) * 64)) * nlen; coloff = 1024 + (ct - 8) * 64; }
    LAS bf16_t* t = (LAS bf16_t*)lds;
    const int chl = tid >> 3, seg = tid & 7;
    u32x4 v[4];
#pragma unroll
    for (int q = 0; q < 4; ++q) v[q] = *(const u32x4*)(src + (size_t)chl * nlen + (tg * 4 + q) * 64 + seg * 8);
    __syncthreads();
#pragma unroll
    for (int q = 0; q < 4; ++q) *(LAS u32x4*)(t + q * 64 * 72 + chl * 72 + seg * 8) = v[q];
    __syncthreads();
#pragma unroll
    for (int q = 0; q < 4; ++q) { const int tl = tid >> 3; unsigned w[4];
#pragma unroll
      for (int j = 0; j < 4; ++j) w[j] = (unsigned)t[q * 64 * 72 + (seg * 8 + 2 * j) * 72 + tl] | ((unsigned)t[q * 64 * 72 + (seg * 8 + 2 * j + 1) * 72 + tl] << 16);
      const size_t row = (ctx ? (size_t)NLAT + b * CTXL : (size_t)b * SEQ) + (tg * 4 + q) * 64 + tl;
      *(u32x4*)((bf16_t*)(P->ws + A_Y) + row * 1280 + coloff + seg * 8) = (u32x4){w[0], w[1], w[2], w[3]}; }
}

#ifndef PH
#define PH 0xFFFF
#endif
#define ON(k) ((PH >> (k)) & 1)
__device__ __forceinline__ int fresh_tid() { int t = threadIdx.x; asm volatile("" : "+v"(t)); return t; }
#ifndef REP2
#define REP2 1
#endif
#ifndef REP3
#define REP3 1
#endif
#ifndef REP4
#define REP4 1
#endif
#ifndef REP5
#define REP5 1
#endif
#ifndef REP7
#define REP7 1
#endif
#ifndef REP8
#define REP8 1
#endif
#ifndef REP11
#define REP11 1
#endif
#define TID fresh_tid()
#define FT const int bid = blockIdx.x, G = gridDim.x, nwaves = G * 8; (void)nwaves; KP P = (KP)__builtin_amdgcn_kernarg_segment_ptr(); asm volatile("" : "+s"(P)); unsigned char* ws = P->ws; (void)ws; const int tid = fresh_tid(); const int lane = tid & 63; const int gwave = bid * 8 + (tid >> 6); (void)lane; (void)gwave;
template <int L>
__device__ __forceinline__ void layer_body(LAS unsigned char* lds) {
    constexpr int l = L;
    constexpr bool first = (L == 0);
        const int M2 = first ? MALL : NLAT;
        if (ON(1)) { FT modulate_rows(P, l, 0, first, MALL, false, gwave, nwaves, lane);
          __syncthreads(); }
        GSYNC();
        { FT pg8::Gemm g{(const bf16_t*)(ws + A_XN), (const bf16_t*)(ws + WS_WIN), MALL, 3328, D}; pg8::StaticOrder S; S.init(MALL, 3328, G, bid);
          EpiMain E{ws}; for (int rep_ = 0; rep_ < REP2; ++rep_) pg8::gemm_phase<EpiMain>(lds, g, S, E, tid);
          { const int nbusy = (66 * 13) % G, nfree = G - nbusy;
            if (bid >= nbusy) { for (int it = bid - nbusy; it < 128 * 16; it += nfree) filt_item(P, l, it, false, lds, tid);
                                if (first) for (int it = bid - nbusy; it < 4 * 16; it += nfree) filt_item(P, l, it, true, lds, tid); }
            __syncthreads(); } }
        GSYNC();
        for (int rep_ = 0; rep_ < REP3; ++rep_) {
          { FT for (int j = bid; j < 256; j += G) hyena_job<14>(P, l, j, lds, tid); }
          { FT for (int j = bid; j < 256; j += G) fnet_job<13>(P, j, lds, tid); }
          if (first) {
            { FT for (int j = bid; j < 256; j += G) hyena_job<9>(P, l, j, lds, tid); }
            { FT for (int j = bid; j < 256; j += G) fnet_job<8>(P, j, lds, tid); }
          }
        }
        GSYNC();
        for (int rep_ = 0; rep_ < REP4; ++rep_) { FT if (G == 256) { for (int j = bid >> 3; j < 132; j += 32) { const int t2 = fresh_tid(); chunk_item(P, l, (bid & 7) * 132 + j, lds, t2); } } else { for (int it = bid; it < 1056; it += G) { const int t2 = fresh_tid(); chunk_item(P, l, it, lds, t2); } } }
        GSYNC();
        for (int rep_ = 0; rep_ < REP5; ++rep_) { FT if (bid < 128) phase_scan(P, lds, tid); else { for (int it = bid - 128; it < NCONV_F + NCONV_A_LATE; it += G - 128) { if (it < NCONV_F) conv_item_F(P, l, it, lds, tid); else conv_item_A(P, l, conv_a_late(it - NCONV_F), lds, tid); } } }
        GSYNC();
        if (ON(6)) { FT
        modulate_rows(P, l, 0, first, M2, false, gwave, nwaves, lane);
        ya_rows(P, l, M2, gwave, nwaves, lane);
        for (int it = bid; it < 2 * 12 * 32; it += G) tr_y_item(P, it, false, lds, tid);
        if (first) for (int it = bid; it < 2 * 12; it += G) tr_y_item(P, it, true, lds, tid);
        }
        __syncthreads();
        GSYNC();
        { FT pg8::Gemm g{(const bf16_t*)(ws + A_XN), (const bf16_t*)(ws + WS_WIN) + (size_t)3328 * D, M2, 3072, D}; pg8::StaticOrder S; S.init(M2, 3072, G, bid);
          EpiGate E{(bf16_t*)(ws + A_GATE)}; for (int rep_ = 0; rep_ < REP7; ++rep_) pg8::gemm_phase<EpiGate>(lds, g, S, E, tid); }
        GSYNC();
        { FT pg8::Gemm g{(const bf16_t*)(ws + A_Y), (const bf16_t*)(ws + WS_WABC), M2, D, 1280}; pg8::StaticOrder S; S.init(M2, D, G, bid);
          EpiMerge E{(const bf16_t*)(ws + A_GATE), (bf16_t*)(ws + A_XN)}; for (int rep_ = 0; rep_ < REP8; ++rep_) pg8::gemm_phase<EpiMerge>(lds, g, S, E, tid); }
        GSYNC();
        { FT const float* mod = (const float*)(ws + WS_MOD) + (size_t)l * 3 * 6144;
          pg8::Gemm g{(const bf16_t*)(ws + A_XN), (const bf16_t*)(ws + WS_WOUT), M2, D, D}; pg8::StaticOrder S; S.init(M2, D, G, bid);
          EpiRes E{first ? P->in[I_X] : P->out, first ? P->in[I_CTX] : (const float*)(ws + WS_HC), P->out, (float*)(ws + WS_HC), mod + 2 * D};
          if (ON(9)) pg8::gemm_phase<EpiRes>(lds, g, S, E, tid); }
        GSYNC();
        if (ON(10)) { FT modulate_rows(P, l, 1, false, M2, false, gwave, nwaves, lane);
 }
        __syncthreads();
        GSYNC();
        { FT pg8::Gemm g{(const bf16_t*)(ws + A_XN), (const bf16_t*)(ws + A_WF1), M2, DFF, D}; pg8::StaticOrder S; S.init(M2, DFF, G, bid);
          EpiRelu2 E{(bf16_t*)(ws + A_ACT)}; for (int rep_ = 0; rep_ < REP11; ++rep_) pg8::gemm_phase<EpiRelu2>(lds, g, S, E, tid);
          if (first) { const int nbusy = (66 * 16) % G, nfree = G - nbusy;
            if (bid >= nbusy) for (int it = bid - nbusy; it < NCONV_A_EARLY; it += nfree) conv_item_A(P, 1, conv_a_early(it), lds, tid);
            __syncthreads(); } }
        GSYNC();
        { FT const float* mod = (const float*)(ws + WS_MOD) + (size_t)l * 3 * 6144;
          pg8::Gemm g{(const bf16_t*)(ws + A_ACT), (const bf16_t*)(ws + A_WF2), NLAT, D, DFF}; pg8::StaticOrder S; S.init(NLAT, D, G, bid);
          EpiRes E{P->out, (const float*)(ws + WS_HC), P->out, (float*)(ws + WS_HC), mod + 5 * D};
          if (ON(12)) pg8::gemm_phase<EpiRes>(lds, g, S, E, tid);
          if (first) {
              pg8::Gemm g2{(const bf16_t*)(ws + A_ACT), (const bf16_t*)(ws + A_WF2), MALL, D, DFF, 4}; pg8::SplitOrder S2{G, bid};
              EpiPart E2{(float*)(ws + A_XN)};
              pg8::gemm_phase<EpiPart>(lds, g2, S2, E2, tid); } }
        GSYNC();
        if (first) { FT const float* mod = (const float*)(ws + WS_MOD) + (size_t)l * 3 * 6144 + 2 * 6144 + 5 * D; const float* part = (const float*)(ws + A_XN); float* hc = (float*)(ws + WS_HC);
          for (int idx = bid * NT + tid; idx < 512 * 256; idx += G * NT) { const int row = idx >> 8, c4 = (idx & 255) * 4; f32x4 a = (f32x4){0.f, 0.f, 0.f, 0.f};
#pragma unroll
              for (int ks = 0; ks < 16; ++ks) a += *(const f32x4*)(part + ((size_t)ks * 512 + row) * D + c4);
              const f32x4 mv = *(const f32x4*)(mod + c4); f32x4* o = (f32x4*)(hc + (size_t)row * D + c4); *o = *o + mv * a; }
          GSYNC(); }
    }

__global__ void __launch_bounds__(NT, 2) hybrid_fwd(Params Parg) {
    extern __shared__ __attribute__((aligned(16))) unsigned char lds_raw[];
    LAS unsigned char* lds = (LAS unsigned char*)lds_raw;

    if (threadIdx.x < 4) ((volatile LAS unsigned*)(lds + LDS_BARW))[threadIdx.x] = 0u;
    __syncthreads();
    if (threadIdx.x == 0) (void)xb_add(&((unsigned*)(((KP)__builtin_amdgcn_kernarg_segment_ptr())->ws + WS_BAR))[XB_XCNT(xb_xcc_id())], 1u);
    { FT
    for (int it = bid; it < 384 + 32 + 260 + NCONV_A_EARLY; it += G) {
        if (!ON(0)) continue;
        if (it < 384) modp_item(P, it, tid);
        else if (it < 416) { const int m = (it - 384) * 512 + tid; float s, c; sincospif((float)m / 8192.0f, &s, &c); ((f32x2*)(ws + WS_TW))[m] = (f32x2){c, -s}; }
        else if (it < 676) hid2_item(P, it - 416, lds, tid);
        else conv_item_A(P, 0, conv_a_early(it - 676), lds, tid);
    } }
    cg::this_grid().sync();
    { FT
    for (int idx = bid * NT + tid; idx < 2 * 3 * 6144; idx += G * NT) { const int n = idx % 6144, lv = idx / 6144, l = lv / 3;
        float a = P->in[I_BMOD][l * 6144 + n]; const float* mp = (const float*)(ws + WS_MODP) + idx;
        for (int kc = 0; kc < 16; ++kc) a += mp[(size_t)kc * 2 * 3 * 6144];
        ((float*)(ws + WS_MOD))[idx] = a; } }
    GSYNC();

    layer_body<0>(lds);
    layer_body<1>(lds);
    { FT const float* gain = P->in[I_FNORM];
      f32x4 g[4];
#pragma unroll
      for (int i = 0; i < 4; ++i) g[i] = *(const f32x4*)(gain + i * 256 + lane * 4);
      for (int r0 = gwave; r0 < NLAT; r0 += 2 * nwaves) { const int r1 = r0 + nwaves; const bool has1 = r1 < NLAT;
          float* h0 = P->out + (size_t)r0 * D; float* h1 = P->out + (size_t)(has1 ? r1 : r0) * D; f32x4 x0[4], x1[4]; float s0 = 0.f, s1 = 0.f;
#pragma unroll
          for (int i = 0; i < 4; ++i) { x0[i] = *(const f32x4*)(h0 + i * 256 + lane * 4); x1[i] = *(const f32x4*)(h1 + i * 256 + lane * 4); }
#pragma unroll
          for (int i = 0; i < 4; ++i) { s0 += x0[i][0] * x0[i][0] + x0[i][1] * x0[i][1] + x0[i][2] * x0[i][2] + x0[i][3] * x0[i][3]; s1 += x1[i][0] * x1[i][0] + x1[i][1] * x1[i][1] + x1[i][2] * x1[i][2] + x1[i][3] * x1[i][3]; }
          for (int o = 32; o >= 1; o >>= 1) { s0 += __shfl_xor(s0, o); s1 += __shfl_xor(s1, o); }
          const float q0 = rsqrtf(s0 * (1.0f / D) + EPS), q1 = rsqrtf(s1 * (1.0f / D) + EPS);
#pragma unroll
          for (int i = 0; i < 4; ++i) { *(f32x4*)(h0 + i * 256 + lane * 4) = x0[i] * q0 * g[i]; if (has1) *(f32x4*)(h1 + i * 256 + lane * 4) = x1[i] * q1 * g[i]; } } }
}

extern "C" void kernel_launch(void* const* d_in, const int* in_sizes, int n_in, void* d_out, int out_size, void* d_ws, size_t ws_size, hipStream_t stream) {
    static int grid_blocks = 0;
    if (!grid_blocks) {
        int dev = 0, cus = 0, per_cu = 0;
        (void)hipGetDevice(&dev);
        (void)hipDeviceGetAttribute(&cus, hipDeviceAttributeMultiprocessorCount, dev);
        (void)hipFuncSetAttribute((const void*)hybrid_fwd, hipFuncAttributeMaxDynamicSharedMemorySize, LDS_BYTES);
        (void)hipOccupancyMaxActiveBlocksPerMultiprocessor(&per_cu, (const void*)hybrid_fwd, NT, LDS_BYTES);
        if (per_cu < 1) per_cu = 1;
        grid_blocks = cus * 1;
        if (ws_size < 256 * MiB) fprintf(stderr, "kernel_launch: workspace too small (%zu)\n", ws_size);
    }
    Params p{};
    for (int i = 0; i < 29; ++i) p.in[i] = (const float*)d_in[i];
    p.out = (float*)d_out; p.ws = (unsigned char*)d_ws;
    (void)hipMemsetAsync((unsigned char*)d_ws + WS_BAR, 0, 16384, stream);
    void* args[] = {&p};
    hipError_t e = hipLaunchCooperativeKernel((const void*)hybrid_fwd, dim3(grid_blocks), dim3(NT), args, LDS_BYTES, stream);
    if (e != hipSuccess) fprintf(stderr, "cooperative launch failed: %s (grid %d)\n", hipGetErrorString(e), grid_blocks);
}
```

```cpp
#include <hip/hip_runtime.h>
#include <hip/hip_cooperative_groups.h>
#include <cstdio>
namespace cg = cooperative_groups;

typedef unsigned short bf16_t;
typedef short bf16x8 __attribute__((ext_vector_type(8)));
typedef float f32x4 __attribute__((ext_vector_type(4)));
typedef float f32x2 __attribute__((ext_vector_type(2)));
typedef unsigned u32x4 __attribute__((ext_vector_type(4)));
typedef unsigned u32x2 __attribute__((ext_vector_type(2)));
#define LAS __attribute__((address_space(3)))

constexpr int D = 1024, SEQ = 8192, CTXL = 256, NLAT = 16384, NCTX = 512, MALL = 16896;
constexpr int INW = 6160, DFF = 4096;
constexpr float EPS = 1e-6f;
constexpr int NT = 512;
constexpr int LDS_BYTES = 147456;
constexpr size_t MiB = 1u << 20;

constexpr size_t WS_MOD   = 4096;
constexpr size_t WS_MODP  = WS_MOD + 2 * 3 * 6144 * 4;
constexpr size_t WS_TW    = WS_MODP + 16 * 2 * 3 * 6144 * 4;
constexpr size_t WS_HID2  = WS_TW + 16384 * 8;
constexpr size_t WS_HID2C = WS_HID2 + 2 * 8192 * 64 * 4;
constexpr size_t WS_WBA   = WS_HID2C + 256 * 64 * 4;
constexpr size_t WS_BA    = WS_WBA + 2 * 16 * 1024 * 4;
constexpr size_t WS_HC    = WS_BA + (size_t)MALL * 16 * 4;
constexpr size_t WS_DG    = WS_HC + 512 * 1024 * 4;
constexpr size_t WS_BAR   = WS_DG + 1056 * 2 * 64 * 4;
constexpr size_t WS_SMALL_END = WS_BAR + 16384;
static_assert(WS_SMALL_END <= 12 * MiB, "small region");
constexpr size_t WS_WIN   = 12 * MiB;
constexpr size_t WS_WABC  = WS_WIN + 12 * MiB + MiB / 2;
constexpr size_t WS_WOUT  = WS_WABC + 2 * MiB + MiB / 2;
constexpr size_t AB       = WS_WOUT + 2 * MiB;
constexpr size_t A_XN     = AB;
constexpr size_t A_DQ     = AB;
constexpr size_t A_DKT    = AB + 16 * MiB + MiB / 2;
constexpr size_t A_QKV    = AB + 33 * MiB;
constexpr size_t A_OF     = A_QKV;
constexpr size_t A_OB     = A_QKV + 16 * MiB + MiB / 2;
constexpr size_t A_Z      = AB + 82 * MiB + MiB / 2;
constexpr size_t A_YBT    = AB + 99 * MiB;
constexpr size_t A_YBTC   = A_YBT + 16 * MiB;
constexpr size_t A_YCT    = A_YBT + 16 * MiB + MiB / 2;
constexpr size_t A_YCTC   = A_YCT + 8 * MiB;
constexpr size_t A_BIG    = AB + 123 * MiB + 3 * MiB / 4;
constexpr size_t A_FNT    = A_BIG;
constexpr size_t A_FNTC   = A_FNT + 8 * MiB;
constexpr size_t A_HYT    = A_BIG + 8 * MiB + MiB / 4;
constexpr size_t A_HYTC   = A_HYT + 24 * MiB;
constexpr size_t A_KF     = A_BIG + 33 * MiB;
constexpr int KF_STRIDE   = 8200;
constexpr size_t A_DW     = A_BIG;
constexpr size_t A_DUT    = A_BIG + 33 * MiB;
constexpr size_t A_DQK    = A_BIG + 66 * MiB;
constexpr size_t A_FILT   = AB + 190 * MiB;
constexpr size_t A_FILTC  = AB + 222 * MiB;
constexpr size_t A_Y      = AB + 184 * MiB + MiB / 4;
constexpr size_t A_GATE   = AB + 82 * MiB + MiB / 2;
constexpr size_t A_WF1    = AB + 66 * MiB;
constexpr size_t A_WF2    = AB + 74 * MiB;
constexpr size_t A_ACT    = AB + 82 * MiB + MiB / 2;
static_assert(A_Y + (size_t)MALL * 1280 * 2 <= 256 * MiB, "ws overflow");
static_assert(A_KF + 256ull * 2 * KF_STRIDE * 8 <= 256 * MiB, "kf overflow");
static_assert(A_ACT + (size_t)MALL * 4096 * 2 <= 256 * MiB, "act overflow");
static_assert(A_GATE + (size_t)MALL * 3072 * 2 <= A_Y, "gate overlap");

struct Params { const float* in[29]; float* out; unsigned char* ws; };
typedef const __attribute__((address_space(4))) Params* KP;
enum { I_X = 0, I_C, I_CTX, I_CCTX, I_WMOD, I_BMOD, I_NORM1, I_NORM2, I_WIN, I_DNCONV, I_ALOG, I_DTB, I_DNON, I_HYCONV, I_HW1, I_HB1, I_HF1,
       I_HW2, I_HB2, I_HF2, I_HW3, I_HBIAS, I_WA, I_WB, I_WC, I_WOUT, I_FF1, I_FF2, I_FNORM };

__device__ __forceinline__ bf16_t f2bf(float f) { return __builtin_bit_cast(bf16_t, (__bf16)f); }
__device__ __forceinline__ float bf2f(bf16_t b) { return __uint_as_float(((unsigned)b) << 16); }
typedef __bf16 bf16x2_t __attribute__((ext_vector_type(2)));
__device__ __forceinline__ unsigned pk2(float lo, float hi) { bf16x2_t v = __builtin_convertvector((f32x2){lo, hi}, bf16x2_t); return __builtin_bit_cast(unsigned, v); }
__device__ __forceinline__ float lo2f(unsigned w) { return __uint_as_float(w << 16); }
__device__ __forceinline__ float hi2f(unsigned w) { return __uint_as_float(w & 0xffff0000u); }
__device__ __forceinline__ float wave_sum(float v) { for (int o = 32; o >= 1; o >>= 1) v += __shfl_xor(v, o); return v; }
__device__ __forceinline__ float sigmoidf(float x) { return __builtin_amdgcn_rcpf(1.0f + __expf(-x)); }
__device__ __forceinline__ float siluf(float x) { return x / (1.0f + __expf(-x)); }
__device__ __forceinline__ f32x2 cmul(f32x2 a, f32x2 b) { return (f32x2){a.x * b.x - a.y * b.y, a.x * b.y + a.y * b.x}; }


#define XB_TMO      128
#define XB_XCNT(j)  (256  + 64 * (j))
#define XB_XSUB(j)  (1280 + 64 * (j))
#define XB_XGEN(j)  (2304 + 64 * (j))
#define XB_TOP      3328
#define XB_TOPGEN   3392
#define XCD_BAR_WORDS 3456
#define XB_SPIN_CAP (1u << 22)
__device__ __forceinline__ unsigned xb_ld(unsigned* p)              { return __hip_atomic_load(p, __ATOMIC_RELAXED, __HIP_MEMORY_SCOPE_AGENT); }
__device__ __forceinline__ unsigned xb_add(unsigned* p, unsigned v) { return __hip_atomic_fetch_add(p, v, __ATOMIC_RELAXED, __HIP_MEMORY_SCOPE_AGENT); }
__device__ __forceinline__ unsigned xb_xcc_id() { return (unsigned)__builtin_amdgcn_s_getreg((3 << 11) | 20) & 0xFu; }
#define XB_SPIN(cond, bar) do { unsigned _sp = 0; while (cond) { __builtin_amdgcn_s_sleep(1); \
    if ((++_sp & 255u) == 0u) { if (xb_ld(&(bar)[XB_TMO])) break; if (_sp > XB_SPIN_CAP) { atomicAdd(&(bar)[XB_TMO], 1u); break; } } } } while (0)
__device__ __forceinline__ void xcd_barrier_complete(unsigned* bar, unsigned x, unsigned& nloc, unsigned& nx) {
    const unsigned G = gridDim.x * gridDim.y * gridDim.z;
    unsigned sum, cnt, mine, sp = 0u;
    for (;;) {
        sum = 0u; cnt = 0u; mine = 0u;
#pragma unroll
        for (unsigned j = 0; j < 16; ++j) { const unsigned c = xb_ld(&bar[XB_XCNT(j)]); sum += c; cnt += (c > 0u) ? 1u : 0u; mine = (j == x) ? c : mine; }
        if (sum == G) break;
        __builtin_amdgcn_s_sleep(1);
        if ((++sp & 255u) == 0u) { if (xb_ld(&bar[XB_TMO])) break; if (sp > XB_SPIN_CAP) { atomicAdd(&bar[XB_TMO], 1u); break; } }
    }
    nloc = mine > 0u ? mine : 1u; nx = cnt > 0u ? cnt : 1u;
}
__device__ __forceinline__ void xcd_barrier(unsigned* bar, volatile LAS unsigned* st) {
    asm volatile("s_waitcnt vmcnt(0)" ::: "memory");
    __syncthreads();
    if (threadIdx.x == 0) {
        const unsigned x = xb_xcc_id();
        __builtin_amdgcn_s_waitcnt(0);
        unsigned nloc = st[0], nx = st[1];
        if (nloc == 0u) { xcd_barrier_complete(bar, x, nloc, nx); st[0] = nloc; st[1] = nx; }
        const unsigned old = xb_add(&bar[XB_XSUB(x)], 1u);
        const unsigned gen = old / nloc;
        if (old + 1u == (gen + 1u) * nloc) {
            __builtin_amdgcn_fence(__ATOMIC_RELEASE, "agent");
            asm volatile("s_waitcnt vmcnt(0)" ::: "memory");
            const unsigned og = xb_add(&bar[XB_TOP], 1u);
            const unsigned tg = og / nx;
            if (og + 1u == (tg + 1u) * nx) xb_add(&bar[XB_TOPGEN], 1u);
            else XB_SPIN(xb_ld(&bar[XB_TOPGEN]) == tg, bar);
            __builtin_amdgcn_fence(__ATOMIC_ACQUIRE, "agent");
            xb_add(&bar[XB_XGEN(x)], 1u);
            asm volatile("s_waitcnt vmcnt(0)" ::: "memory");
        } else {
            XB_SPIN(xb_ld(&bar[XB_XGEN(x)]) == gen, bar);
            __builtin_amdgcn_fence(__ATOMIC_ACQUIRE, "agent");
            asm volatile("s_waitcnt vmcnt(0)" ::: "memory");
        }
    }
    __syncthreads();
}
constexpr int LDS_BARW = LDS_BYTES - 16;
#define GSYNC() xcd_barrier((unsigned*)(((KP)__builtin_amdgcn_kernarg_segment_ptr())->ws + WS_BAR), (volatile LAS unsigned*)(lds + LDS_BARW))

namespace pg8 {
constexpr int BM = 256, BK = 64, HALF = 128, HTB = HALF * BK * 2, STAGE_BYTES = 8 * HTB, NXCD = 8, WGM = 8;
__device__ __forceinline__ int lds_byte(int r, int c) { const int st = (r >> 4) * 2 + (c >> 5), rr = r & 15, cc = c & 31, ob = rr * 64 + cc * 2; return st * 1024 + (ob ^ (((ob >> 9) & 1) << 5)); }
__device__ __forceinline__ void stage_rc(int b, int& R, int& C) { const int st = b / 1024, sb = b % 1024, swz = sb ^ (((sb >> 9) & 1) << 5); R = (st >> 1) * 16 + swz / 64; C = (st & 1) * 32 + (swz % 64) / 2; }
__device__ __forceinline__ int perm32(int rho) { const int n = rho >> 4, i = rho & 15; return 8 * (i >> 2) + 4 * n + (i & 3); }
struct Unit { int pm, pn, ks; };
struct Gemm { const bf16_t* A; const bf16_t* Bt; int M, N, K; int ntile; };
struct StaticOrder {
    int nM, nN, nwg, G, c;
    __device__ void init(int M, int N, int G_, int c_) { nM = M / BM; nN = N / BM; nwg = nM * nN; G = G_; c = c_; }
    __device__ bool next(int i, Unit& u) const {
        const long L = (long)i * G + c; if (L >= nwg) return false;
        int wgid = (int)L; { const int q = nwg / NXCD, r = nwg % NXCD, xcd = wgid % NXCD, off = wgid / NXCD; wgid = (xcd < r ? xcd * (q + 1) : r * (q + 1) + (xcd - r) * q) + off; }
        const int nig = WGM * nN, gid = wgid / nig, fm = gid * WGM, gsz = (nM - fm) < WGM ? (nM - fm) : WGM;
        u.pm = fm + ((wgid % nig) % gsz); u.pn = (wgid % nig) / gsz; u.ks = 0; return true;
    }
};
struct SplitOrder {
    int G, c;
    __device__ bool next(int i, Unit& u) const { const long L = (long)i * G + c; if (L >= 128) return false; const int tile = (int)L >> 4; u.pm = 64 + (tile >> 2); u.pn = tile & 3; u.ks = (int)L & 15; return true; }
};
__device__ __forceinline__ unsigned cvt_pk_bf16(float lo, float hi) { return pk2(lo, hi); }

template <class Epi, class Sched>
__device__ __forceinline__ void gemm_phase(LAS unsigned char* lds, const Gemm g, const Sched& S, const Epi& E, const int tid) {
    const int wid = __builtin_amdgcn_readfirstlane(tid >> 6), lane = tid & 63, wr = wid >> 2, wc = wid & 3, fr = lane & 15, fq = lane >> 4;
    const int K = g.K, nt = g.ntile ? g.ntile : K / BK; const size_t ksl = (size_t)g.ntile * BK * 2;
    unsigned voffA[2], voffB[2];
#pragma unroll
    for (int i = 0; i < 2; ++i) { int R, C; stage_rc(tid * 16 + i * 8192, R, C); const int Rb = Epi::PERM ? ((R & ~31) + perm32(R & 31)) : R;
        voffA[i] = (unsigned)(R * K + C) * 2u; voffB[i] = (unsigned)(Rb * K + C) * 2u; }
    const size_t kstep = (size_t)(BK * 2);
    const size_t hstep = (size_t)HALF * K * 2;
    const size_t tstep = 2 * hstep;
    const unsigned ldsw = (unsigned)wid * 1024u;
    const int aoff = lds_byte(wr * 64 + fr, fq * 8), boff = lds_byte(wc * 32 + fr, fq * 8);
#define PG8_SA(b, h) (((b) * 2 + (h)) * HTB)
#define PG8_SB(b, h) ((4 + (b) * 2 + (h)) * HTB)
#define PG8_STAGE(bufoff, gbase, voff) do { _Pragma("unroll") for (int _i = 0; _i < 2; ++_i) \
        __builtin_amdgcn_global_load_lds((const unsigned*)((const char*)(gbase) + (voff)[_i]), (LAS unsigned*)(lds + (bufoff) + ldsw + _i * 8192), 16, 0, 0); } while (0)
#define PG8_LDA(dst, b, h) do { _Pragma("unroll") for (int m = 0; m < 4; ++m) _Pragma("unroll") for (int k = 0; k < 2; ++k) dst[m][k] = *(const LAS bf16x8*)(lds + PG8_SA(b, h) + aoff + m * 2048 + k * 1024); } while (0)
#define PG8_LDB(dst, b, h) do { _Pragma("unroll") for (int n = 0; n < 2; ++n) _Pragma("unroll") for (int k = 0; k < 2; ++k) dst[n][k] = *(const LAS bf16x8*)(lds + PG8_SB(b, h) + boff + n * 2048 + k * 1024); } while (0)
#define PG8_MMA(ai, bj, At, Bt) do { __builtin_amdgcn_s_setprio(1); _Pragma("unroll") for (int m = 0; m < 4; ++m) _Pragma("unroll") for (int n = 0; n < 2; ++n) _Pragma("unroll") for (int k = 0; k < 2; ++k) \
        acc[ai][bj][m][n] = __builtin_amdgcn_mfma_f32_16x16x32_bf16(Bt[n][k], At[m][k], acc[ai][bj][m][n], 0, 0, 0); __builtin_amdgcn_s_setprio(0); } while (0)
#define PG8_WAIT_V(n) asm volatile("s_waitcnt vmcnt(" #n ")" ::: "memory")
#define PG8_WAIT_L(n) asm volatile("s_waitcnt lgkmcnt(" #n ")" ::: "memory")
#define PG8_BAR __builtin_amdgcn_s_barrier()
#define PG8_SCHED __builtin_amdgcn_sched_barrier(0)
    Unit cur, nxt; int ui = 0;
    if (!S.next(0, cur)) return;
    f32x4 acc[2][2][4][2];
#pragma unroll
    for (int a = 0; a < 2; ++a)
#pragma unroll
        for (int b = 0; b < 2; ++b)
#pragma unroll
            for (int m = 0; m < 4; ++m)
#pragma unroll
                for (int n = 0; n < 2; ++n) acc[a][b][m][n] = (f32x4){0.f, 0.f, 0.f, 0.f};
    bf16x8 At[4][2], B0[2][2], B1[2][2];
    const char* cA = (const char*)g.A + (size_t)cur.pm * tstep + cur.ks * ksl; const char* cB = (const char*)g.Bt + (size_t)cur.pn * tstep + cur.ks * ksl;
    PG8_STAGE(PG8_SB(0, 0), cB, voffB); PG8_STAGE(PG8_SA(0, 0), cA, voffA); PG8_STAGE(PG8_SB(0, 1), cB + hstep, voffB); PG8_STAGE(PG8_SA(0, 1), cA + hstep, voffA);
    if (wr == 1) PG8_BAR;
    PG8_WAIT_V(4); PG8_BAR;
    PG8_STAGE(PG8_SB(1, 0), cB + kstep, voffB); PG8_STAGE(PG8_SA(1, 0), cA + kstep, voffA); PG8_STAGE(PG8_SB(1, 1), cB + hstep + kstep, voffB);
    PG8_WAIT_V(6); PG8_BAR;
    for (;;) {
        const bool has_next = S.next(ui + 1, nxt);
        const char* nA = has_next ? (const char*)g.A + (size_t)nxt.pm * tstep + nxt.ks * ksl : cA; const char* nB = has_next ? (const char*)g.Bt + (size_t)nxt.pn * tstep + nxt.ks * ksl : cB;
        for (int t = 0; t < nt; t += 2) {
            const bool last = (t == nt - 2);
            const char* a1 = cA + (size_t)(t + 1) * kstep;
            const char* a2 = last ? nA : cA + (size_t)(t + 2) * kstep; const char* b2 = last ? nB : cB + (size_t)(t + 2) * kstep;
            const char* a3 = a2 + kstep; const char* b3 = b2 + kstep;
            if constexpr (Epi::RESCALE) { if (t == 8 || t == 16) E.rescale(acc, cur, wr, wc, fr, fq, t == 8 ? 0 : 1); }
            PG8_LDB(B0, 0, 0); PG8_SCHED; PG8_LDA(At, 0, 0); PG8_STAGE(PG8_SA(1, 1), a1 + hstep, voffA);
            PG8_WAIT_L(8); PG8_BAR; PG8_WAIT_L(0); PG8_MMA(0, 0, At, B0); PG8_BAR; PG8_SCHED;
            PG8_LDB(B1, 0, 1); PG8_STAGE(PG8_SB(0, 0), b2, voffB);
            PG8_BAR; PG8_WAIT_L(0); PG8_MMA(0, 1, At, B1); PG8_BAR;
            PG8_LDA(At, 0, 1); PG8_STAGE(PG8_SA(0, 0), a2, voffA);
            PG8_BAR; PG8_WAIT_L(0); PG8_MMA(1, 0, At, B0); PG8_BAR; PG8_SCHED;
            PG8_STAGE(PG8_SB(0, 1), b2 + hstep, voffB);
            PG8_WAIT_V(6); PG8_BAR; PG8_MMA(1, 1, At, B1); PG8_BAR;
            PG8_LDB(B0, 1, 0); PG8_SCHED; PG8_LDA(At, 1, 0); PG8_STAGE(PG8_SA(0, 1), a2 + hstep, voffA);
            PG8_WAIT_L(8); PG8_BAR; PG8_WAIT_L(0); PG8_MMA(0, 0, At, B0); PG8_BAR; PG8_SCHED;
            PG8_LDB(B1, 1, 1); PG8_STAGE(PG8_SB(1, 0), b3, voffB);
            PG8_BAR; PG8_WAIT_L(0); PG8_MMA(0, 1, At, B1); PG8_BAR;
            PG8_LDA(At, 1, 1); PG8_STAGE(PG8_SA(1, 0), a3, voffA);
            PG8_BAR; PG8_WAIT_L(0); PG8_MMA(1, 0, At, B0); PG8_BAR; PG8_SCHED;
            PG8_STAGE(PG8_SB(1, 1), b3 + hstep, voffB);
            PG8_WAIT_V(6); PG8_BAR; PG8_MMA(1, 1, At, B1); PG8_BAR;
        }
        E(acc, cur, wr, wc, fr, fq);
        if (!has_next) break;
#pragma unroll
        for (int a = 0; a < 2; ++a)
#pragma unroll
            for (int b = 0; b < 2; ++b)
#pragma unroll
                for (int m = 0; m < 4; ++m)
#pragma unroll
                    for (int n = 0; n < 2; ++n) acc[a][b][m][n] = (f32x4){0.f, 0.f, 0.f, 0.f};
        cur = nxt; cA = nA; cB = nB; ++ui;
    }
    PG8_WAIT_V(0);
    if (wr == 0) PG8_BAR;
    PG8_BAR;
#undef PG8_SA
#undef PG8_SB
#undef PG8_STAGE
#undef PG8_LDA
#undef PG8_LDB
#undef PG8_MMA
#undef PG8_WAIT_V
#undef PG8_WAIT_L
#undef PG8_BAR
#undef PG8_SCHED
}
}
using pg8::Unit; using pg8::HALF; using pg8::BM; using pg8::cvt_pk_bf16;

struct EpiMain {
    static constexpr bool PERM = false, RESCALE = false;
    unsigned char* ws;
    __device__ __forceinline__ void operator()(const f32x4 (&acc)[2][2][4][2], const Unit& u, int wr, int wc, int fr, int fq) const {
        const int row0 = u.pm * BM + wr * 64 + fr;
        if (u.pn < 8) {
            bf16_t* base; int ld, colt;
            if (u.pn < 6) { base = (bf16_t*)(ws + A_QKV); ld = 1536; colt = u.pn * BM; } else { base = (bf16_t*)(ws + A_Z); ld = 512; colt = (u.pn - 6) * BM; }
            const int col0 = colt + wc * 32 + 4 * fq;
#pragma unroll
            for (int ai = 0; ai < 2; ++ai)
#pragma unroll
                for (int m = 0; m < 4; ++m) { bf16_t* rowp = base + (size_t)(row0 + ai * HALF + m * 16) * ld + col0;
#pragma unroll
                    for (int bj = 0; bj < 2; ++bj)
#pragma unroll
                        for (int n = 0; n < 2; ++n) { const f32x4 v = acc[ai][bj][m][n]; u32x2 w; w.x = cvt_pk_bf16(v[0], v[1]); w.y = cvt_pk_bf16(v[2], v[3]); *(u32x2*)(rowp + bj * HALF + n * 16) = w; } }
        } else if (u.pn == 12) {
            if (wc == 0) { float* ba = (float*)(ws + WS_BA);
#pragma unroll
                for (int ai = 0; ai < 2; ++ai)
#pragma unroll
                    for (int m = 0; m < 4; ++m) *(f32x4*)(ba + (size_t)(row0 + ai * HALF + m * 16) * 16 + 4 * fq) = acc[ai][0][m][0]; }
        } else {
            const int chb = (u.pn - 8) * BM + wc * 32 + 4 * fq;
            int b, t0, nlen; bf16_t* fbase; bf16_t* hbase;
            if (u.pm < 64) { b = u.pm >> 5; t0 = (u.pm & 31) * BM + wr * 64 + fr; nlen = SEQ; fbase = (bf16_t*)(ws + A_FNT); hbase = (bf16_t*)(ws + A_HYT); }
            else { b = u.pm - 64; t0 = wr * 64 + fr; nlen = CTXL; fbase = (bf16_t*)(ws + A_FNTC); hbase = (bf16_t*)(ws + A_HYTC); }
#pragma unroll
            for (int bj = 0; bj < 2; ++bj)
#pragma unroll
                for (int n = 0; n < 2; ++n)
#pragma unroll
                    for (int j = 0; j < 4; ++j) { const int ch = chb + bj * HALF + n * 16 + j;
                        bf16_t* p = (ch < 256) ? fbase + ((size_t)(b * 256 + ch)) * nlen : hbase + ((size_t)(b * 768 + ch - 256)) * nlen;
#pragma unroll
                        for (int ai = 0; ai < 2; ++ai)
#pragma unroll
                            for (int m = 0; m < 4; ++m) p[t0 + ai * HALF + m * 16] = f2bf(acc[ai][bj][m][n][j]); }
        }
    }
};
struct EpiGate {
    static constexpr bool PERM = true, RESCALE = false;
    bf16_t* O;
    __device__ __forceinline__ void operator()(const f32x4 (&acc)[2][2][4][2], const Unit& u, int wr, int wc, int fr, int fq) const {
        const int row0 = u.pm * BM + wr * 64 + fr, col0 = u.pn * BM + wc * 32 + 8 * fq;
#pragma unroll
        for (int ai = 0; ai < 2; ++ai)
#pragma unroll
            for (int m = 0; m < 4; ++m) { bf16_t* rowp = O + (size_t)(row0 + ai * HALF + m * 16) * 3072 + col0;
#pragma unroll
                for (int bj = 0; bj < 2; ++bj) { f32x4 v0 = acc[ai][bj][m][0], v1 = acc[ai][bj][m][1];
#pragma unroll
                    for (int j = 0; j < 4; ++j) { v0[j] = sigmoidf(v0[j]); v1[j] = sigmoidf(v1[j]); }
                    u32x4 w; w.x = cvt_pk_bf16(v0[0], v0[1]); w.y = cvt_pk_bf16(v0[2], v0[3]); w.z = cvt_pk_bf16(v1[0], v1[1]); w.w = cvt_pk_bf16(v1[2], v1[3]);
                    *(u32x4*)(rowp + bj * HALF) = w; } }
    }
};
struct EpiRelu2 {
    static constexpr bool PERM = true, RESCALE = false;
    bf16_t* O;
    __device__ __forceinline__ void operator()(const f32x4 (&acc)[2][2][4][2], const Unit& u, int wr, int wc, int fr, int fq) const {
        const int row0 = u.pm * BM + wr * 64 + fr, col0 = u.pn * BM + wc * 32 + 8 * fq;
#pragma unroll
        for (int ai = 0; ai < 2; ++ai)
#pragma unroll
            for (int m = 0; m < 4; ++m) { bf16_t* rowp = O + (size_t)(row0 + ai * HALF + m * 16) * DFF + col0;
#pragma unroll
                for (int bj = 0; bj < 2; ++bj) { f32x4 v0 = acc[ai][bj][m][0], v1 = acc[ai][bj][m][1];
#pragma unroll
                    for (int j = 0; j < 4; ++j) { const float a = fmaxf(v0[j], 0.f), b = fmaxf(v1[j], 0.f); v0[j] = a * a; v1[j] = b * b; }
                    u32x4 w; w.x = cvt_pk_bf16(v0[0], v0[1]); w.y = cvt_pk_bf16(v0[2], v0[3]); w.z = cvt_pk_bf16(v1[0], v1[1]); w.w = cvt_pk_bf16(v1[2], v1[3]);
                    *(u32x4*)(rowp + bj * HALF) = w; } }
    }
};
struct EpiMerge {
    static constexpr bool PERM = true, RESCALE = true;
    const bf16_t* G; bf16_t* O;
    __device__ __forceinline__ void rescale(f32x4 (&acc)[2][2][4][2], const Unit& u, int wr, int wc, int fr, int fq, int seg) const {
        const int row0 = u.pm * BM + wr * 64 + fr, col0 = u.pn * BM + wc * 32 + 8 * fq;
        const bf16_t* gbase = G + (size_t)row0 * 3072 + seg * 1024 + col0;
#pragma unroll
        for (int ai = 0; ai < 2; ++ai)
#pragma unroll
            for (int mp = 0; mp < 2; ++mp) {
                u32x4 gn[2][2], gd[2][2];
#pragma unroll
                for (int mm = 0; mm < 2; ++mm)
#pragma unroll
                    for (int bj = 0; bj < 2; ++bj) { const bf16_t* gp = gbase + (size_t)(ai * HALF + (mp * 2 + mm) * 16) * 3072 + bj * HALF; gn[mm][bj] = *(const u32x4*)gp; gd[mm][bj] = *(const u32x4*)(gp + 1024); }
#pragma unroll
                for (int mm = 0; mm < 2; ++mm)
#pragma unroll
                    for (int bj = 0; bj < 2; ++bj) { const int m = mp * 2 + mm; const u32x4 n_ = gn[mm][bj], d_ = gd[mm][bj];
                        f32x4 v0 = acc[ai][bj][m][0], v1 = acc[ai][bj][m][1];
                        v0[0] *= lo2f(n_.x) * __builtin_amdgcn_rcpf(lo2f(d_.x)); v0[1] *= hi2f(n_.x) * __builtin_amdgcn_rcpf(hi2f(d_.x));
                        v0[2] *= lo2f(n_.y) * __builtin_amdgcn_rcpf(lo2f(d_.y)); v0[3] *= hi2f(n_.y) * __builtin_amdgcn_rcpf(hi2f(d_.y));
                        v1[0] *= lo2f(n_.z) * __builtin_amdgcn_rcpf(lo2f(d_.z)); v1[1] *= hi2f(n_.z) * __builtin_amdgcn_rcpf(hi2f(d_.z));
                        v1[2] *= lo2f(n_.w) * __builtin_amdgcn_rcpf(lo2f(d_.w)); v1[3] *= hi2f(n_.w) * __builtin_amdgcn_rcpf(hi2f(d_.w));
                        acc[ai][bj][m][0] = v0; acc[ai][bj][m][1] = v1; }
                asm volatile("" ::: "memory"); }
        __builtin_amdgcn_sched_barrier(0);
    }
    __device__ __forceinline__ void operator()(const f32x4 (&acc)[2][2][4][2], const Unit& u, int wr, int wc, int fr, int fq) const {
        const int row0 = u.pm * BM + wr * 64 + fr, col0 = u.pn * BM + wc * 32 + 8 * fq;
#pragma unroll
        for (int ai = 0; ai < 2; ++ai)
#pragma unroll
            for (int m = 0; m < 4; ++m) { const size_t r = (size_t)(row0 + ai * HALF + m * 16);
#pragma unroll
                for (int bj = 0; bj < 2; ++bj) { const u32x4 g2 = *(const u32x4*)(G + r * 3072 + 2048 + col0 + bj * HALF);
                    const f32x4 v0 = acc[ai][bj][m][0], v1 = acc[ai][bj][m][1];
                    u32x4 w; w.x = cvt_pk_bf16(v0[0] * lo2f(g2.x), v0[1] * hi2f(g2.x)); w.y = cvt_pk_bf16(v0[2] * lo2f(g2.y), v0[3] * hi2f(g2.y));
                    w.z = cvt_pk_bf16(v1[0] * lo2f(g2.z), v1[1] * hi2f(g2.z)); w.w = cvt_pk_bf16(v1[2] * lo2f(g2.w), v1[3] * hi2f(g2.w));
                    *(u32x4*)(O + r * 1024 + col0 + bj * HALF) = w; } }
    }
};
struct EpiRes {
    static constexpr bool PERM = false, RESCALE = false;
    const float* base_lat; const float* base_ctx; float* out_lat; float* out_ctx; const float* mod;
    __device__ __forceinline__ void operator()(const f32x4 (&acc)[2][2][4][2], const Unit& u, int wr, int wc, int fr, int fq) const {
        const int col0 = u.pn * BM + wc * 32 + 4 * fq;
        const float* bs; float* os; int v, rloc;
        if (u.pm < 64) { bs = base_lat; os = out_lat; v = u.pm >> 5; rloc = u.pm * BM; } else { bs = base_ctx; os = out_ctx; v = 2; rloc = (u.pm - 64) * BM; }
        const int row0 = rloc + wr * 64 + fr;
        f32x4 mv[2][2];
#pragma unroll
        for (int bj = 0; bj < 2; ++bj)
#pragma unroll
            for (int n = 0; n < 2; ++n) mv[bj][n] = *(const f32x4*)(mod + v * 6144 + col0 + bj * HALF + n * 16);
#pragma unroll
        for (int ai = 0; ai < 2; ++ai)
#pragma unroll
            for (int m = 0; m < 4; ++m) { const size_t off = (size_t)(row0 + ai * HALF + m * 16) * D + col0;
#pragma unroll
                for (int bj = 0; bj < 2; ++bj)
#pragma unroll
                    for (int n = 0; n < 2; ++n) { const f32x4 b = *(const f32x4*)(bs + off + bj * HALF + n * 16); *(f32x4*)(os + off + bj * HALF + n * 16) = b + mv[bj][n] * acc[ai][bj][m][n]; }
                if (m == 3) asm volatile("" ::: "memory"); }
    }
};

struct EpiPart {
    static constexpr bool PERM = false, RESCALE = false;
    float* part;
    __device__ __forceinline__ void operator()(const f32x4 (&acc)[2][2][4][2], const Unit& u, int wr, int wc, int fr, int fq) const {
        const int col0 = u.pn * BM + wc * 32 + 4 * fq; const int row0 = (u.pm - 64) * BM + wr * 64 + fr;
        float* base = part + (size_t)u.ks * 512 * D;
#pragma unroll
        for (int ai = 0; ai < 2; ++ai)
#pragma unroll
            for (int m = 0; m < 4; ++m) { float* rowp = base + (size_t)(row0 + ai * HALF + m * 16) * D + col0;
#pragma unroll
                for (int bj = 0; bj < 2; ++bj)
#pragma unroll
                    for (int n = 0; n < 2; ++n) *(f32x4*)(rowp + bj * HALF + n * 16) = acc[ai][bj][m][n]; }
    }
};

__device__ __forceinline__ void tr_tile(const float* src, int ld_src, bf16_t* dst, int ld_dst, LAS float* t, int tid) {
#pragma unroll
    for (int i = 0; i < 8; ++i) { const int k = (tid >> 6) + 8 * i, n = tid & 63; t[k * 65 + n] = src[(size_t)k * ld_src + n]; }
    __syncthreads();
    { const int n = tid >> 3, ks = (tid & 7) * 8; u32x4 w;
      w.x = pk2(t[(ks + 0) * 65 + n], t[(ks + 1) * 65 + n]); w.y = pk2(t[(ks + 2) * 65 + n], t[(ks + 3) * 65 + n]);
      w.z = pk2(t[(ks + 4) * 65 + n], t[(ks + 5) * 65 + n]); w.w = pk2(t[(ks + 6) * 65 + n], t[(ks + 7) * 65 + n]);
      *(u32x4*)(dst + (size_t)n * ld_dst + ks) = w; }
    __syncthreads();
}
constexpr int NCONV_A = 1536 + 128 + 64 + 256 + 128 + 4;
__device__ __forceinline__ void conv_item_A(KP P, int l, int it, LAS unsigned char* lds, int tid) {
    LAS float* t = (LAS float*)lds; unsigned char* ws = P->ws;
    if (it < 1536) { const int kt = it & 15, ntile = it >> 4, n0 = ntile * 64, sc = n0 < 2048 ? n0 : n0 + 16;
        tr_tile(P->in[I_WIN] + (size_t)l * D * INW + (size_t)(kt * 64) * INW + sc, INW, (bf16_t*)(ws + WS_WIN) + (size_t)(n0 < 3072 ? n0 : n0 + 256) * D + kt * 64, D, t, tid); return; }
    it -= 1536;
    if (it < 128) { const int kt = it & 7, ntile = it >> 3;
        tr_tile(P->in[I_WA] + (size_t)l * 512 * D + (size_t)(kt * 64) * D + ntile * 64, D, (bf16_t*)(ws + WS_WABC) + (size_t)(ntile * 64) * 1280 + kt * 64, 1280, t, tid); return; }
    it -= 128;
    if (it < 64) { const int kt = it & 3, ntile = it >> 2;
        tr_tile(P->in[I_WC] + (size_t)l * 256 * D + (size_t)(kt * 64) * D + ntile * 64, D, (bf16_t*)(ws + WS_WABC) + (size_t)(ntile * 64) * 1280 + 1024 + kt * 64, 1280, t, tid); return; }
    it -= 64;
    if (it < 256) { const int kt = it & 15, ntile = it >> 4;
        tr_tile(P->in[I_WOUT] + (size_t)l * D * D + (size_t)(kt * 64) * D + ntile * 64, D, (bf16_t*)(ws + WS_WOUT) + (size_t)(ntile * 64) * D + kt * 64, D, t, tid); return; }
    it -= 256;
    if (it < 128) {
        const int ntile = it & 15, g = (it >> 4) & 3, part = it >> 6;
        const float* src = P->in[I_WB] + (size_t)l * 256 * D + (size_t)(g * 64) * D + ntile * 64;
        LAS float* tr = t + 64 * 65;
#pragma unroll
        for (int i = 0; i < 8; ++i) { const int k = (tid >> 6) + 8 * i, n = tid & 63; t[k * 65 + n] = src[(size_t)k * D + n]; }
        if (tid < 64) { float s, c; sincospif((float)tid / 32.0f, &s, &c); tr[tid] = part ? s : c; }
        __syncthreads();
        { const int n = tid >> 3, cs = (tid & 7) * 8; float o[8];
#pragma unroll
          for (int jj = 0; jj < 8; ++jj) o[jj] = 0.f;
#pragma unroll 2
          for (int m = 0; m < 64; ++m) { const float tv = t[m * 65 + n];
#pragma unroll
              for (int jj = 0; jj < 8; ++jj) o[jj] += tr[(m * (cs + jj)) & 63] * tv; }
          u32x4 w; w.x = pk2(o[0], o[1]); w.y = pk2(o[2], o[3]); w.z = pk2(o[4], o[5]); w.w = pk2(o[6], o[7]);
          *(u32x4*)((bf16_t*)(ws + WS_WABC) + (size_t)(ntile * 64 + n) * 1280 + 512 + part * 256 + g * 64 + cs) = w; }
        __syncthreads(); return; }
    it -= 128;
    { bf16_t* dst = (bf16_t*)(ws + WS_WIN) + (size_t)(3072 + it * 64) * D;
      for (int i = 0; i < 16; ++i) { const int idx = i * 512 + tid; const int r = idx >> 7, k0 = (idx & 127) * 8; u32x4 w = (u32x4){0u, 0u, 0u, 0u};
          if (it == 0 && r < 16) { const float* sp = P->in[I_WIN] + (size_t)l * D * INW + (size_t)k0 * INW + 2048 + r;
              w.x = pk2(sp[0], sp[INW]); w.y = pk2(sp[2 * INW], sp[3 * INW]); w.z = pk2(sp[4 * INW], sp[5 * INW]); w.w = pk2(sp[6 * INW], sp[7 * INW]); }
          *(u32x4*)(dst + (size_t)r * D + k0) = w; } }
}
constexpr int NCONV_A_EARLY = 768 + 4, NCONV_A_LATE = NCONV_A - NCONV_A_EARLY;
__device__ __forceinline__ int conv_a_early(int j) { return j < 768 ? j : 2112 + (j - 768); }
__device__ __forceinline__ int conv_a_late(int j) { return 768 + j; }
constexpr int NCONV_F = 2048;
__device__ __forceinline__ void conv_item_F(KP P, int l, int it, LAS unsigned char* lds, int tid) {
    LAS float* t = (LAS float*)lds; unsigned char* ws = P->ws;
    if (it < 1024) { const int kt = it & 15, ntile = it >> 4;
        tr_tile(P->in[I_FF1] + (size_t)l * D * DFF + (size_t)(kt * 64) * DFF + ntile * 64, DFF, (bf16_t*)(ws + A_WF1) + (size_t)(ntile * 64) * D + kt * 64, D, t, tid); return; }
    it -= 1024;
    { const int kt = it & 63, ntile = it >> 6;
      tr_tile(P->in[I_FF2] + (size_t)l * DFF * D + (size_t)(kt * 64) * D + ntile * 64, D, (bf16_t*)(ws + A_WF2) + (size_t)(ntile * 64) * DFF + kt * 64, DFF, t, tid); }
}

__device__ __forceinline__ void modp_item(KP P, int it, int tid) {
    const int kc = it & 15, nb = (it >> 4) % 12, l = it / 192; const int n = nb * 512 + tid;
    const float* w = P->in[I_WMOD] + (size_t)l * D * 6144 + (size_t)(kc * 64) * 6144 + n;
    float a0 = 0.f, a1 = 0.f, a2 = 0.f;
#pragma unroll 8
    for (int k = 0; k < 64; ++k) { const int kk = kc * 64 + k; const float wv = w[(size_t)k * 6144];
        a0 += siluf(P->in[I_C][kk]) * wv; a1 += siluf(P->in[I_C][D + kk]) * wv; a2 += siluf(P->in[I_CCTX][kk]) * wv; }
    float* o = (float*)(P->ws + WS_MODP) + ((size_t)(kc * 2 + l) * 3) * 6144 + n;
    o[0] = a0; o[6144] = a1; o[2 * 6144] = a2;
}
__device__ __forceinline__ void hid2_item(KP P, int it, LAS unsigned char* lds, int tid) {
    int l, n, p0; float* dst;
    if (it < 256) { l = it >> 7; n = SEQ; p0 = (it & 127) * 64; dst = (float*)(P->ws + WS_HID2) + ((size_t)l * SEQ + p0) * 64; }
    else { l = 0; n = CTXL; p0 = (it - 256) * 64; dst = (float*)(P->ws + WS_HID2C) + (size_t)p0 * 64; }
    LAS float* feats = (LAS float*)lds; LAS float* h1 = feats + 64 * 33;
    for (int idx = tid; idx < 64 * 33; idx += NT) { const int p = idx / 33, f = idx % 33; const float pos = (float)(p0 + p); float v;
        if (f == 0) v = pos / (float)(n - 1);
        else { const int bi = (f - 1) & 15; const float band = 1e-4f + (15.0f - 1e-4f) * (float)bi / 15.0f; const float ang = (6.283185307179586f / (float)n) * pos * band; v = (f <= 16) ? cosf(ang) : -sinf(ang); }
        feats[idx] = v; }
    __syncthreads();
    const int p = tid >> 3, og = (tid & 7) * 8;
    { const float* w1 = P->in[I_HW1] + (size_t)l * 33 * 64; float a[8];
#pragma unroll
      for (int j = 0; j < 8; ++j) a[j] = P->in[I_HB1][l * 64 + og + j];
#pragma unroll 11
      for (int f = 0; f < 33; ++f) { const float x = feats[p * 33 + f];
#pragma unroll
          for (int j = 0; j < 8; ++j) a[j] += x * w1[f * 64 + og + j]; }
#pragma unroll
      for (int j = 0; j < 8; ++j) h1[p * 64 + og + j] = sinf(P->in[I_HF1][l * 64 + og + j] * a[j]); }
    __syncthreads();
    { const float* w2 = P->in[I_HW2] + (size_t)l * 64 * 64; float a[8];
#pragma unroll
      for (int j = 0; j < 8; ++j) a[j] = P->in[I_HB2][l * 64 + og + j];
#pragma unroll 8
      for (int f = 0; f < 64; ++f) { const float x = h1[p * 64 + f];
#pragma unroll
          for (int j = 0; j < 8; ++j) a[j] += x * w2[f * 64 + og + j]; }
#pragma unroll
      for (int j = 0; j < 8; ++j) dst[(size_t)p * 64 + og + j] = sinf(P->in[I_HF2][l * 64 + og + j] * a[j]); }
    __syncthreads();
}


__device__ __forceinline__ void filt_item(KP P, int l, int it, bool ctx, LAS unsigned char* lds, int tid) {
    const int n = ctx ? CTXL : SEQ; const int ntt = n / 64; const int tt = it % ntt, ct = it / ntt;
    const float* hid = ctx ? (const float*)(P->ws + WS_HID2C) : (const float*)(P->ws + WS_HID2) + (size_t)l * SEQ * 64;
    float* dst = (float*)(P->ws + (ctx ? A_FILTC : A_FILT));
    LAS float* hs = (LAS float*)lds; LAS float* wsm = hs + 64 * 64;
    __syncthreads();
#pragma unroll
    for (int i = 0; i < 8; ++i) { const int r = (tid >> 6) + 8 * i, c = tid & 63;
        hs[r * 64 + c] = hid[(size_t)(tt * 64 + r) * 64 + c];
        wsm[r * 65 + c] = P->in[I_HW3][(size_t)l * 64 * 1024 + (size_t)r * 1024 + ct * 64 + c]; }
    __syncthreads();
    { const int col = tid & 63, ts = (tid >> 6) * 8; float o[8];
#pragma unroll
      for (int jj = 0; jj < 8; ++jj) o[jj] = 0.f;
#pragma unroll 2
      for (int j4 = 0; j4 < 16; ++j4) { const float w0 = wsm[(4 * j4) * 65 + col], w1 = wsm[(4 * j4 + 1) * 65 + col], w2 = wsm[(4 * j4 + 2) * 65 + col], w3 = wsm[(4 * j4 + 3) * 65 + col];
#pragma unroll
          for (int jj = 0; jj < 8; ++jj) { const f32x4 h4 = *(const LAS f32x4*)(hs + (ts + jj) * 64 + 4 * j4); o[jj] += h4[0] * w0 + h4[1] * w1 + h4[2] * w2 + h4[3] * w3; } }
      float* op = dst + (size_t)(ct * 64 + col) * n + tt * 64 + ts;
      *(f32x4*)op = (f32x4){o[0], o[1], o[2], o[3]}; *(f32x4*)(op + 4) = (f32x4){o[4], o[5], o[6], o[7]}; }
}

__device__ __forceinline__ const float* hrow(KP P, int r, bool from_input) {
    if (r < NLAT) return (from_input ? P->in[I_X] : P->out) + (size_t)r * D;
    return (from_input ? P->in[I_CTX] : (const float*)(P->ws + WS_HC)) + (size_t)(r - NLAT) * D;
}
__device__ __forceinline__ void modulate_rows(KP P, int l, int which, bool from_input, int nrows, bool do_ba, int gwave, int nwaves, int lane) {
    const float* gain = P->in[which ? I_NORM2 : I_NORM1] + l * D;
    const float* mod = (const float*)(P->ws + WS_MOD) + (size_t)l * 3 * 6144;
    bf16_t* XN = (bf16_t*)(P->ws + A_XN);
    f32x4 g[4];
#pragma unroll
    for (int i = 0; i < 4; ++i) g[i] = *(const f32x4*)(gain + i * 256 + lane * 4);
    for (int r0 = gwave; r0 < nrows; r0 += 2 * nwaves) {
        const int r1 = r0 + nwaves; const bool has1 = r1 < nrows; const int rr1 = has1 ? r1 : r0;
        const float* h0 = hrow(P, r0, from_input); const float* h1 = hrow(P, rr1, from_input);
        f32x4 x0[4], x1[4]; float ss0 = 0.f, ss1 = 0.f;
#pragma unroll
        for (int i = 0; i < 4; ++i) { x0[i] = *(const f32x4*)(h0 + i * 256 + lane * 4); x1[i] = *(const f32x4*)(h1 + i * 256 + lane * 4); }
#pragma unroll
        for (int i = 0; i < 4; ++i) { ss0 += x0[i][0] * x0[i][0] + x0[i][1] * x0[i][1] + x0[i][2] * x0[i][2] + x0[i][3] * x0[i][3];
                                      ss1 += x1[i][0] * x1[i][0] + x1[i][1] * x1[i][1] + x1[i][2] * x1[i][2] + x1[i][3] * x1[i][3]; }
        for (int o = 32; o >= 1; o >>= 1) { ss0 += __shfl_xor(ss0, o); ss1 += __shfl_xor(ss1, o); }
        const float rs0 = rsqrtf(ss0 * (1.0f / D) + EPS), rs1 = rsqrtf(ss1 * (1.0f / D) + EPS);
        const int v0 = r0 < SEQ ? 0 : (r0 < NLAT ? 1 : 2), v1 = rr1 < SEQ ? 0 : (rr1 < NLAT ? 1 : 2);
        const float* sh0 = mod + v0 * 6144 + (which ? 3 : 0) * D; const float* sh1 = mod + v1 * 6144 + (which ? 3 : 0) * D;
#pragma unroll
        for (int i = 0; i < 4; ++i) { const int c = i * 256 + lane * 4;
            const f32x4 a1 = *(const f32x4*)(sh0 + D + c), a0 = *(const f32x4*)(sh0 + c), b1 = *(const f32x4*)(sh1 + D + c), b0 = *(const f32x4*)(sh1 + c);
#pragma unroll
            for (int j = 0; j < 4; ++j) { x0[i][j] = x0[i][j] * rs0 * g[i][j] * (1.0f + a1[j]) + a0[j]; x1[i][j] = x1[i][j] * rs1 * g[i][j] * (1.0f + b1[j]) + b0[j]; }
            u32x2 w; w.x = pk2(x0[i][0], x0[i][1]); w.y = pk2(x0[i][2], x0[i][3]); *(u32x2*)(XN + (size_t)r0 * D + c) = w;
            if (has1) { u32x2 w2; w2.x = pk2(x1[i][0], x1[i][1]); w2.y = pk2(x1[i][2], x1[i][3]); *(u32x2*)(XN + (size_t)r1 * D + c) = w2; } }
    }
}

template <int LOGN>
__device__ __forceinline__ void fft_lds(LAS f32x2* buf, const f32x2* __restrict__ tw, const bool inv, const int tid) {
    constexpr int N = 1 << LOGN;
    int Ns = 1;
#pragma unroll 1
    for (int p = 0; p < LOGN / 2; ++p) {
        constexpr int T = N / 4, NB = (T + NT - 1) / NT;
        const float rNs4 = 0.25f / (float)Ns;
        f32x2 v[NB][4]; int j0s[NB];
#pragma unroll
        for (int i = 0; i < NB; ++i) { const int j = tid + NT * i;
            if (T >= NT || j < T) {
                const int k = j & (Ns - 1); const float rev = (float)k * rNs4;
                f32x2 a0 = buf[j], a1 = buf[j + T], a2 = buf[j + 2 * T], a3 = buf[j + 3 * T];
                if (Ns != 1) {
                    f32x2 w1 = (f32x2){__builtin_amdgcn_cosf(rev), -__builtin_amdgcn_sinf(rev)};
                    if (inv) w1.y = -w1.y;
                    const f32x2 w2 = cmul(w1, w1), w3 = cmul(w1, w2);
                    a1 = cmul(a1, w1); a2 = cmul(a2, w2); a3 = cmul(a3, w3); }
                const f32x2 t0 = a0 + a2, t1 = a0 - a2, t2 = a1 + a3, d = a1 - a3;
                const f32x2 t3 = inv ? (f32x2){-d.y, d.x} : (f32x2){d.y, -d.x};
                v[i][0] = t0 + t2; v[i][1] = t1 + t3; v[i][2] = t0 - t2; v[i][3] = t1 - t3;
                j0s[i] = ((j - k) << 2) + k;
                if (i & 1) asm volatile("" : "+v"(v[i][0]), "+v"(v[i][1]), "+v"(v[i][2]), "+v"(v[i][3]) :: "memory"); } }
        __syncthreads();
#pragma unroll
        for (int i = 0; i < NB; ++i) { const int j = tid + NT * i;
            if (T >= NT || j < T) {
                if (Ns == 1) {
                    *(LAS f32x4*)(buf + j0s[i]) = (f32x4){v[i][0].x, v[i][0].y, v[i][1].x, v[i][1].y};
                    *(LAS f32x4*)(buf + j0s[i] + 2) = (f32x4){v[i][2].x, v[i][2].y, v[i][3].x, v[i][3].y};
                } else { buf[j0s[i]] = v[i][0]; buf[j0s[i] + Ns] = v[i][1]; buf[j0s[i] + 2 * Ns] = v[i][2]; buf[j0s[i] + 3 * Ns] = v[i][3]; } } }
        __syncthreads();
        Ns <<= 2;
    }
    if (LOGN & 1) {
        constexpr int T = N / 2, NB = (T + NT - 1) / NT;
        f32x2 v[NB][2]; int j0s[NB];
#pragma unroll
        for (int i = 0; i < NB; ++i) { const int j = tid + NT * i;
            if (T >= NT || j < T) {
                const int k = j & (Ns - 1); const float rev = (float)k * (0.5f / (float)Ns);
                f32x2 a0 = buf[j], a1 = buf[j + T]; f32x2 w1 = (f32x2){__builtin_amdgcn_cosf(rev), -__builtin_amdgcn_sinf(rev)}; if (inv) w1.y = -w1.y;
                a1 = cmul(a1, w1); v[i][0] = a0 + a1; v[i][1] = a0 - a1; j0s[i] = ((j - k) << 1) + k; } }
        __syncthreads();
#pragma unroll
        for (int i = 0; i < NB; ++i) { const int j = tid + NT * i; if (T >= NT || j < T) { buf[j0s[i]] = v[i][0]; buf[j0s[i] + Ns] = v[i][1]; } }
        __syncthreads();
    }
}

__device__ __forceinline__ float sconv(const bf16_t* p, int t, int n, float w0, float w1, float w2) {
    float a = w1 * bf2f(p[t]); if (t > 0) a += w0 * bf2f(p[t - 1]); if (t + 1 < n) a += w2 * bf2f(p[t + 1]); return a;
}

template <int LOGN2>
__device__ __forceinline__ void hyena_job(KP P, int l, int c, LAS unsigned char* lds, int tid) {
    constexpr int N2 = 1 << LOGN2, n = N2 / 2, NI = (n + NT - 1) / NT;
    LAS f32x2* buf = (LAS f32x2*)lds; LAS float* sm = (LAS float*)(lds + 131072);
    unsigned char* ws = P->ws;
    const f32x2* tw = (const f32x2*)(ws + WS_TW);
    const float* hid = (n == SEQ) ? (const float*)(ws + WS_HID2) + (size_t)l * SEQ * 64 : (const float*)(ws + WS_HID2C);
    f32x2* KF = (f32x2*)(ws + A_KF) + (size_t)blockIdx.x * 2 * KF_STRIDE;
    const bf16_t* hyt = (n == SEQ) ? (const bf16_t*)(ws + A_HYT) : (const bf16_t*)(ws + A_HYTC);
    bf16_t* yct = (n == SEQ) ? (bf16_t*)(ws + A_YCT) : (bf16_t*)(ws + A_YCTC);
    __syncthreads();
    const float* filt = (const float*)(ws + ((n == SEQ) ? A_FILT : A_FILTC));
    const float dmin = -3.0701134573253945f, dmax = -15.350567286626972f;
    const float delta0 = fabsf(dmin + (dmax - dmin) * (float)c / 511.0f), delta1 = fabsf(dmin + (dmax - dmin) * (float)(256 + c) / 511.0f);
    float s0 = 0.f, s1 = 0.f;
#pragma unroll 4
    for (int i = 0; i < NI; ++i) { const int t = tid + NT * i;
        if (n >= NT || t < n) {
            float f00 = filt[(size_t)c * n + t], f01 = filt[(size_t)(256 + c) * n + t], f10 = filt[(size_t)(512 + c) * n + t], f11 = filt[(size_t)(768 + c) * n + t];
            const float tn = (float)t / (float)(n - 1); const float d0 = __expf(-tn * delta0), d1 = __expf(-tn * delta1);
            f00 *= d0; f10 *= d0; f01 *= d1; f11 *= d1;
            buf[t] = (f32x2){f00, f01}; s0 += fabsf(f00); s1 += fabsf(f01);
            if (t >= 1) { buf[N2 - t] = (f32x2){f10, f11}; s0 += fabsf(f10); s1 += fabsf(f11); }
            else buf[n] = (f32x2){0.f, 0.f};
        } }
    s0 = wave_sum(s0); s1 = wave_sum(s1);
    if ((tid & 63) == 0) { sm[256 + (tid >> 6)] = s0; sm[264 + (tid >> 6)] = s1; }
    __syncthreads();
    float t0 = 0.f, t1 = 0.f;
#pragma unroll
    for (int w = 0; w < 8; ++w) { t0 += sm[256 + w]; t1 += sm[264 + w]; }
    const float inv0 = 1.0f / (t0 * (float)N2), inv1 = 1.0f / (t1 * (float)N2);
    fft_lds<LOGN2>(buf, tw, false, tid);
#pragma unroll 4
    for (int i = 0; i < (n + NT) / NT; ++i) { const int k = tid + NT * i;
        if (k <= n) { const f32x2 z = buf[k], w = buf[(N2 - k) & (N2 - 1)];
            KF[k] = (f32x2){0.5f * (z.x + w.x) * inv0, 0.5f * (z.y - w.y) * inv0};
            KF[KF_STRIDE + k] = (f32x2){0.5f * (z.y + w.y) * inv1, -0.5f * (z.x - w.x) * inv1}; } }
    __threadfence_block();
    __syncthreads();
    float zr[NI], zi[NI];
    const float* cw = P->in[I_HYCONV] + (size_t)l * 3 * 768;
    { const int row = 512 + c; const float w0 = cw[row], w1 = cw[768 + row], w2 = cw[1536 + row];
#pragma unroll
      for (int i = 0; i < NI; ++i) { const int t = tid + NT * i; if (n >= NT || t < n) { zr[i] = sconv(hyt + (size_t)row * n, t, n, w0, w1, w2); zi[i] = sconv(hyt + (size_t)(768 + row) * n, t, n, w0, w1, w2); } } }
#pragma unroll 1
    for (int o = 0; o < 2; ++o) {
#pragma unroll
        for (int i = 0; i < NI; ++i) { const int t = tid + NT * i; if (n >= NT || t < n) { buf[t] = (f32x2){zr[i], zi[i]}; buf[t + n] = (f32x2){0.f, 0.f}; } }
        __syncthreads();
        fft_lds<LOGN2>(buf, tw, false, tid);
        const f32x2* Ko = KF + o * KF_STRIDE;
#pragma unroll 4
        for (int i = 0; i < (N2 + NT - 1) / NT; ++i) { const int k = tid + NT * i;
            if (N2 >= NT || k < N2) { f32x2 kk; if (k <= n) kk = Ko[k]; else { kk = Ko[N2 - k]; kk.y = -kk.y; } buf[k] = cmul(buf[k], kk); } }
        __syncthreads();
        fft_lds<LOGN2>(buf, tw, true, tid);
        const int row = o * 256 + c; const float w0 = cw[row], w1 = cw[768 + row], w2 = cw[1536 + row];
        const float bias = P->in[I_HBIAS][l * 512 + o * 256 + c];
#pragma unroll
        for (int i = 0; i < NI; ++i) { const int t = tid + NT * i;
            if (n >= NT || t < n) { const f32x2 cv = buf[t];
                const float x0 = sconv(hyt + (size_t)row * n, t, n, w0, w1, w2), x1 = sconv(hyt + (size_t)(768 + row) * n, t, n, w0, w1, w2);
                zr[i] = x0 * (cv.x + bias * zr[i]); zi[i] = x1 * (cv.y + bias * zi[i]); } }
        __syncthreads();
    }
#pragma unroll
    for (int i = 0; i < NI; ++i) { const int t = tid + NT * i; if (n >= NT || t < n) { yct[(size_t)c * n + t] = f2bf(zr[i]); yct[(size_t)(256 + c) * n + t] = f2bf(zi[i]); } }
}

template <int LOGN>
__device__ __forceinline__ void fnet_job(KP P, int ch, LAS unsigned char* lds, int tid) {
    constexpr int N = 1 << LOGN, NI = (N + NT - 1) / NT;
    LAS f32x2* buf = (LAS f32x2*)lds; unsigned char* ws = P->ws;
    const f32x2* tw = (const f32x2*)(ws + WS_TW);
    const bf16_t* fnt = (N == SEQ) ? (const bf16_t*)(ws + A_FNT) : (const bf16_t*)(ws + A_FNTC);
    bf16_t* ybt = (N == SEQ) ? (bf16_t*)(ws + A_YBT) : (bf16_t*)(ws + A_YBTC);
    const float s = rsqrtf((float)N * 64.0f);
    __syncthreads();
#pragma unroll 4
    for (int i = 0; i < NI; ++i) { const int t = tid + NT * i; if (N >= NT || t < N) buf[t] = (f32x2){bf2f(fnt[(size_t)ch * N + t]), bf2f(fnt[(size_t)(256 + ch) * N + t])}; }
    __syncthreads();
    fft_lds<LOGN>(buf, tw, false, tid);
#pragma unroll 4
    for (int i = 0; i < NI; ++i) { const int k = tid + NT * i;
        if (N >= NT || k < N) { const f32x2 z = buf[k], w = buf[(N - k) & (N - 1)];
            ybt[(size_t)ch * N + k] = f2bf(0.5f * s * (z.x + w.x)); ybt[(size_t)(256 + ch) * N + k] = f2bf(0.5f * s * (z.y - w.y));
            ybt[(size_t)(512 + ch) * N + k] = f2bf(0.5f * s * (z.y + w.y)); ybt[(size_t)(768 + ch) * N + k] = f2bf(-0.5f * s * (z.x - w.x)); } }
    __syncthreads();
}

constexpr int CL_RAW = 0;
constexpr int CL_QS = 50688, CL_KS = CL_QS + 64 * 136 * 2, CL_VS = CL_KS + 64 * 136 * 2;
constexpr int CL_AM = CL_VS + 64 * 136 * 2;
constexpr int CL_GS = CL_AM + 32768;
static_assert(CL_GS + 3 * 512 <= LDS_BYTES, "chunk-local LDS");
template <int DIR, int ISW>
__device__ __forceinline__ void solve_col(unsigned char* ws, LAS unsigned char* lds, size_t it2, int col) {
    asm volatile("" : "+v"(lds));
    const LAS float* AM = (const LAS float*)(lds + CL_AM) + DIR * 4096;
    const LAS float* BS = (const LAS float*)(lds + CL_GS) + 128 + DIR * 64; const LAS float* EG = (const LAS float*)(lds + CL_GS) + 256 + DIR * 64;
    const LAS bf16_t* src = ISW ? (const LAS bf16_t*)(lds + CL_KS) + (col - 128) : (const LAS bf16_t*)(lds + CL_VS) + col;
    float x[64];
#pragma unroll
    for (int i = 0; i < 64; ++i) x[i] = 0.f;
    f32x4 c0, c1, c2, c3;
    { const volatile LAS f32x4* ap = (const volatile LAS f32x4*)AM; c0 = ap[0]; c1 = ap[1]; c2 = ap[2]; c3 = ap[3]; }
#pragma unroll
    for (int i = 0; i < 64; ++i) { const int ri = DIR ? 63 - i : i; float s = bf2f(src[ri * 136]) * BS[i]; if (ISW) s *= EG[i];
        float s1 = 0.f, s2 = 0.f, s3 = 0.f;
#pragma unroll
        for (int jc = 0; jc <= i / 16; ++jc) {
            const int ni = (jc < i / 16) ? i : i + 1, nj = (jc < i / 16) ? jc + 1 : 0;
            f32x4 n0 = c0, n1 = c1, n2 = c2, n3 = c3;
            if (ni < 64) { const volatile LAS f32x4* ap = (const volatile LAS f32x4*)(AM + ni * 64 + nj * 16); n0 = ap[0]; n1 = ap[1]; n2 = ap[2]; n3 = ap[3]; }
#pragma unroll
            for (int jj = 0; jj < 4; ++jj) { s -= c0[jj] * x[jc * 16 + jj]; s1 -= c1[jj] * x[jc * 16 + 4 + jj]; s2 -= c2[jj] * x[jc * 16 + 8 + jj]; s3 -= c3[jj] * x[jc * 16 + 12 + jj]; }
            asm volatile("" : "+v"(s), "+v"(s1), "+v"(s2), "+v"(s3), "+v"(n0), "+v"(n1), "+v"(n2), "+v"(n3) :: "memory");
            c0 = n0; c1 = n1; c2 = n2; c3 = n3; }
        x[i] = (s + s1) + (s2 + s3); }
    if (!ISW) { bf16_t* dut = (bf16_t*)(ws + A_DUT) + (it2 + DIR) * 8192 + col * 4;
#pragma unroll
        for (int i4 = 0; i4 < 16; ++i4) *(u32x2*)(dut + i4 * 512) = (u32x2){pk2(x[i4 * 4], x[i4 * 4 + 1]), pk2(x[i4 * 4 + 2], x[i4 * 4 + 3])}; }
    else { const int kc = col - 128; bf16_t* dw = (bf16_t*)(ws + A_DW) + (it2 + DIR) * 8192 + (((kc >> 5) * 64 + ((kc >> 3) & 3) * 16) * 8 + (kc & 7));
#pragma unroll
        for (int i = 0; i < 64; ++i) dw[((i >> 4) * 256 + (i & 15)) * 8] = f2bf(x[i]); }
}
__device__ __forceinline__ void chunk_item(KP P, int l, int item, LAS unsigned char* lds, int tid) {
    unsigned char* ws = P->ws;
    int b, h, cc, rowbase; bool isctx;
    if (item < 1024) { isctx = false; cc = item & 127; h = (item >> 7) & 3; b = item >> 9; rowbase = b * SEQ + cc * 64; }
    else { isctx = true; const int q = item - 1024; cc = q & 3; h = (q >> 2) & 3; b = q >> 4; rowbase = NLAT + b * CTXL + cc * 64; }
    const bf16_t* QKV = (const bf16_t*)(ws + A_QKV);
    LAS bf16_t* raw = (LAS bf16_t*)(lds + CL_RAW);
    const int lane = tid & 63, wid = tid >> 6;
    __syncthreads();
#pragma unroll 1
    for (int comp = 0; comp < 3; ++comp) {
#pragma unroll 1
        for (int ib = 0; ib < 8; ib += 4) { u32x4 v[4];
#pragma unroll
          for (int i = 0; i < 4; ++i) { const int idx = tid + NT * (ib + i); const int seg = idx & 15, pr = idx >> 4, ky = pr / 66, gx = pr % 66 - 1; int srow = -1;
              if (idx < 3 * 66 * 16) {
                  if (!isctx) { const int gr = cc + ky - 1; if (gr >= 0 && gr < 128 && gx >= 0 && gx < 64) srow = b * SEQ + gr * 64 + gx; }
                  else { const int pos = cc * 64 + gx; if (ky == 1 && pos >= 0 && pos < CTXL) srow = NLAT + b * CTXL + pos; } }
              const u32x4 lv = *(const u32x4*)(QKV + (size_t)(srow >= 0 ? srow : 0) * 1536 + comp * 512 + h * 128 + seg * 8);
              v[i] = srow >= 0 ? lv : (u32x4){0u, 0u, 0u, 0u}; }
#pragma unroll
          for (int i = 0; i < 4; ++i) { const int idx = tid + NT * (ib + i); if (idx < 3 * 66 * 16) *(LAS u32x4*)(raw + (size_t)idx * 8) = v[i]; } }
        __syncthreads();
        { const int tok = tid >> 3, cg8 = tid & 7; float a[16];
#pragma unroll
          for (int j = 0; j < 16; ++j) a[j] = 0.f;
          const float* cw = P->in[I_DNCONV] + (size_t)l * 9 * 1536 + comp * 512 + h * 128 + cg8 * 16;
#pragma unroll
          for (int ky = 0; ky < 3; ++ky)
#pragma unroll
              for (int kx = 0; kx < 3; ++kx) { const LAS bf16_t* rp = raw + (size_t)(ky * 66 + tok + kx) * 128 + cg8 * 16; const float* wp = cw + (ky * 3 + kx) * 1536;
                  const u32x4 r0 = *(const LAS u32x4*)rp, r1 = *(const LAS u32x4*)(rp + 8); const unsigned rr[8] = {r0.x, r0.y, r0.z, r0.w, r1.x, r1.y, r1.z, r1.w};
#pragma unroll
                  for (int j = 0; j < 8; ++j) { a[2 * j] += lo2f(rr[j]) * wp[2 * j]; a[2 * j + 1] += hi2f(rr[j]) * wp[2 * j + 1]; } }
          float ss = 0.f;
#pragma unroll
          for (int j = 0; j < 16; ++j) { a[j] = siluf(a[j]); ss += a[j] * a[j]; }
          float sc = 1.0f;
          if (comp < 2) { ss += __shfl_xor(ss, 1); ss += __shfl_xor(ss, 2); ss += __shfl_xor(ss, 4); sc = rsqrtf(ss + EPS); if (comp == 0) sc *= 0.08838834764831845f; }
          LAS bf16_t* dst = (LAS bf16_t*)(lds + (comp == 0 ? CL_QS : (comp == 1 ? CL_KS : CL_VS))) + tok * 136 + cg8 * 16;
          u32x4 w0, w1; w0.x = pk2(a[0] * sc, a[1] * sc); w0.y = pk2(a[2] * sc, a[3] * sc); w0.z = pk2(a[4] * sc, a[5] * sc); w0.w = pk2(a[6] * sc, a[7] * sc);
          w1.x = pk2(a[8] * sc, a[9] * sc); w1.y = pk2(a[10] * sc, a[11] * sc); w1.z = pk2(a[12] * sc, a[13] * sc); w1.w = pk2(a[14] * sc, a[15] * sc);
          *(LAS u32x4*)dst = w0; *(LAS u32x4*)(dst + 8) = w1; }
        __syncthreads();
    }
    { const int mat = wid >> 2, mt = wid & 3, r16 = lane & 15, q4 = lane >> 4;
      const LAS bf16_t* As = (const LAS bf16_t*)(lds + (mat ? CL_QS : CL_KS)); const LAS bf16_t* Ks = (const LAS bf16_t*)(lds + CL_KS);
      LAS float* outm = (LAS float*)(lds + CL_RAW) + mat * 64 * 65;
      bf16x8 af[4];
#pragma unroll
      for (int ks = 0; ks < 4; ++ks) af[ks] = *(const LAS bf16x8*)(As + (mt * 16 + r16) * 136 + ks * 32 + q4 * 8);
#pragma unroll
      for (int ntile = 0; ntile < 4; ++ntile) { f32x4 acc = (f32x4){0.f, 0.f, 0.f, 0.f};
#pragma unroll
          for (int ks = 0; ks < 4; ++ks) { const bf16x8 bfr = *(const LAS bf16x8*)(Ks + (ntile * 16 + r16) * 136 + ks * 32 + q4 * 8); acc = __builtin_amdgcn_mfma_f32_16x16x32_bf16(af[ks], bfr, acc, 0, 0, 0); }
#pragma unroll
          for (int rg = 0; rg < 4; ++rg) outm[(mt * 16 + q4 * 4 + rg) * 65 + ntile * 16 + r16] = acc[rg]; } }
    LAS float* GS = (LAS float*)(lds + CL_GS); LAS float* BS = GS + 128; LAS float* EG = GS + 256;
    if (tid < 128) { const int dir = tid >> 6, ip = tid & 63, i = dir ? 63 - ip : ip;
        const float* ba = (const float*)(ws + WS_BA) + (size_t)(rowbase + i) * 16;
        const float beta = sigmoidf(ba[dir * 4 + h]); const float av = ba[8 + dir * 4 + h] + P->in[I_DTB][l * 8 + dir * 4 + h];
        const float sp = av > 20.f ? av : log1pf(expf(av));
        float g = -expf(P->in[I_ALOG][l * 8 + dir * 4 + h]) * sp;
        for (int o = 1; o < 64; o <<= 1) { const float tv = __shfl_up(g, o); if (ip >= o) g += tv; }
        GS[tid] = g; BS[tid] = beta; EG[tid] = expf(g); }
    __syncthreads();
    const size_t it2 = (size_t)item * 2;
    { LAS float* KK = (LAS float*)(lds + CL_RAW); LAS float* QKr = KK + 64 * 65; LAS float* AM = (LAS float*)(lds + CL_AM);
      bf16_t* DQK = (bf16_t*)(ws + A_DQK);
      for (int idx = tid; idx < 8192; idx += NT) { const int dir = idx >> 12, ip = (idx >> 6) & 63, jp = idx & 63; const int ri = dir ? 63 - ip : ip, rj = dir ? 63 - jp : jp;
          const float dec = (ip >= jp) ? expf(GS[dir * 64 + ip] - GS[dir * 64 + jp]) : 0.f;
          AM[idx] = (ip > jp) ? BS[dir * 64 + ip] * KK[ri * 65 + rj] * dec : 0.f;
          DQK[(it2 + dir) * 4096 + ((((ip >> 4) * 2 + (jp >> 5)) * 64 + ((jp >> 3) & 3) * 16 + (ip & 15)) * 8 + (jp & 7))] = f2bf(QKr[ri * 65 + rj] * dec); } }
    __syncthreads();
    { const int dir = tid >> 8, col = tid & 255;
      if (dir == 0) { if (col < 128) solve_col<0, 0>(ws, lds, it2, col); else solve_col<0, 1>(ws, lds, it2, col); }
      else { if (col < 128) solve_col<1, 0>(ws, lds, it2, col); else solve_col<1, 1>(ws, lds, it2, col); } }
    { bf16_t* dq = (bf16_t*)(ws + A_DQ) + (size_t)item * 8192; const LAS bf16_t* QS = (const LAS bf16_t*)(lds + CL_QS);
      for (int idx = tid; idx < 1024; idx += NT) { const int r = idx >> 4, seg = idx & 15; *(u32x4*)(dq + ((((r >> 4) * 4 + (seg >> 2)) * 64 + (seg & 3) * 16 + (r & 15)) * 8)) = *(const LAS u32x4*)(QS + r * 136 + seg * 8); }
      bf16_t* dkt = (bf16_t*)(ws + A_DKT) + (size_t)item * 8192; const LAS bf16_t* KS = (const LAS bf16_t*)(lds + CL_KS);
      { const int kd = tid >> 2, is = (tid & 3) * 16; unsigned w[8];
#pragma unroll
        for (int j = 0; j < 8; ++j) w[j] = (unsigned)KS[(is + 2 * j) * 136 + kd] | ((unsigned)KS[(is + 2 * j + 1) * 136 + kd] << 16);
        const int mtk = kd >> 4, rk = kd & 15, ksk = is >> 5, q0 = (is >> 3) & 3;
        *(u32x4*)(dkt + (((mtk * 2 + ksk) * 64 + q0 * 16 + rk) * 8)) = (u32x4){w[0], w[1], w[2], w[3]}; *(u32x4*)(dkt + (((mtk * 2 + ksk) * 64 + (q0 + 1) * 16 + rk) * 8)) = (u32x4){w[4], w[5], w[6], w[7]}; }
      if (tid < 128) ((float*)(ws + WS_DG))[it2 * 64 + tid] = GS[tid]; }
    __syncthreads();
}

struct ScanOps { bf16x8 fa[4]; bf16x8 fb[2]; bf16x8 fc[2]; u32x2 ut; f32x4 g; float glast; };
struct ScanOff { unsigned a, u, b, c, g; };
__device__ __forceinline__ void scan_load(unsigned char* ws, ScanOps& o, const ScanOff& f, int step, int bh, int dir, bool lowhalf, int& rowbase_out) {
    int item, rowbase;
    if (step < 4) { const int cc = dir ? 3 - step : step; item = 1024 + bh * 4 + cc; rowbase = NLAT + (bh >> 2) * CTXL + cc * 64; }
    else { const int lc = step - 4, cc = dir ? 127 - lc : lc; item = bh * 128 + cc; rowbase = (bh >> 2) * SEQ + cc * 64; }
    rowbase_out = rowbase;
    const size_t it2 = (size_t)item * 2 + dir;
    const unsigned char* pA = lowhalf ? ws + A_DW + it2 * 16384 : ws + A_DQ + (size_t)item * 16384;
    const unsigned char* pU = ws + A_DUT + it2 * 16384; const unsigned char* pB = ws + A_DQK + it2 * 8192;
    const unsigned char* pC = ws + A_DKT + (size_t)item * 16384; const unsigned char* pG = ws + WS_DG + it2 * 256;
#pragma unroll
    for (int ks = 0; ks < 4; ++ks) o.fa[ks] = *(const bf16x8*)(pA + f.a + ks * 1024);
    if (lowhalf) o.ut = *(const u32x2*)(pU + f.u);
    else {
#pragma unroll
        for (int ks = 0; ks < 2; ++ks) o.fb[ks] = *(const bf16x8*)(pB + f.b + ks * 1024); }
#pragma unroll
    for (int ks = 0; ks < 2; ++ks) o.fc[ks] = *(const bf16x8*)(pC + f.c + ks * 1024);
    o.g = *(const f32x4*)(pG + f.g); o.glast = *(const float*)(pG + 252);
}
__device__ __forceinline__ void phase_scan(KP P, LAS unsigned char* lds, int tid) {
    const int id = blockIdx.x; if (id >= 128) return;
    unsigned char* ws = P->ws;
    const int vs = (id >> 3) & 7, dir = (id >> 6) & 1, bh = id & 7, h = bh & 3;
    const int lane = tid & 63, wid = __builtin_amdgcn_readfirstlane(tid >> 6), r16 = lane & 15, q4 = lane >> 4, w4 = wid & 3;
    const bool lowhalf = wid < 4;
    LAS bf16_t* ST = (LAS bf16_t*)lds;
    LAS bf16_t* UT = ST + 16 * 136;
    LAS bf16_t* U2T = UT + 16 * 72;
    unsigned char* Obuf = ws + (dir ? A_OB : A_OF);
    ScanOff f;
    { const int ip = w4 * 16 + r16, ri = dir ? 63 - ip : ip;
      f.a = lowhalf ? (unsigned)(((w4 * 4) * 64 + q4 * 16 + r16) * 16) : (unsigned)((((ri >> 4) * 4) * 64 + q4 * 16 + (ri & 15)) * 16);
      f.u = (unsigned)((((w4 * 4 + q4) * 128) + vs * 16 + r16) * 8);
      f.b = (unsigned)(((w4 * 2) * 64 + q4 * 16 + r16) * 16);
      f.c = (unsigned)(((wid * 2) * 64 + q4 * 16 + r16) * 16);
      f.g = (unsigned)((w4 * 16 + q4 * 4) * 4); }
    const int ipo = w4 * 16 + q4 * 4; const int tok0 = dir ? 63 - ipo : ipo; const int ostep = dir ? -1024 : 1024;
    const unsigned offO = (unsigned)((tok0 * 512 + h * 128 + vs * 16 + r16) * 2);
    __syncthreads();
    for (int i = tid; i < 16 * 136; i += NT) ST[i] = 0;
    f32x4 Sacc = (f32x4){0.f, 0.f, 0.f, 0.f};
    ScanOps ops[3]; int rbs[3];
    scan_load(ws, ops[0], f, 0, bh, dir, lowhalf, rbs[0]);
    scan_load(ws, ops[1], f, 1, bh, dir, lowhalf, rbs[1]);
    scan_load(ws, ops[2], f, 2, bh, dir, lowhalf, rbs[2]);
#define SCAN_STEP(cur, rowbase, stepn) do { \
        asm volatile("s_waitcnt lgkmcnt(0)" ::: "memory"); __builtin_amdgcn_s_barrier(); asm volatile("" ::: "memory"); \
        f32x4 acc = (f32x4){0.f, 0.f, 0.f, 0.f}; \
        _Pragma("unroll") for (int ks = 0; ks < 4; ++ks) { const bf16x8 sf = *(const LAS bf16x8*)(ST + r16 * 136 + ks * 32 + q4 * 8); acc = __builtin_amdgcn_mfma_f32_16x16x32_bf16(cur.fa[ks], sf, acc, 0, 0, 0); } \
        const float gl = __expf(cur.glast); \
        if (lowhalf) { \
            float u[4], u2[4]; \
            u[0] = lo2f(cur.ut.x) - acc[0]; u[1] = hi2f(cur.ut.x) - acc[1]; u[2] = lo2f(cur.ut.y) - acc[2]; u[3] = hi2f(cur.ut.y) - acc[3]; \
            _Pragma("unroll") for (int rg = 0; rg < 4; ++rg) u2[rg] = u[rg] * __expf(cur.glast - cur.g[rg]); \
            *(LAS u32x2*)(UT + r16 * 72 + ipo) = (u32x2){pk2(u[0], u[1]), pk2(u[2], u[3])}; \
            if (!dir) *(LAS u32x2*)(U2T + r16 * 72 + ipo) = (u32x2){pk2(u2[0], u2[1]), pk2(u2[2], u2[3])}; \
            else *(LAS u32x2*)(U2T + r16 * 72 + 60 - ipo) = (u32x2){pk2(u2[3], u2[2]), pk2(u2[1], u2[0])}; \
        } else { \
            _Pragma("unroll") for (int rg = 0; rg < 4; ++rg) acc[rg] *= __expf(cur.g[rg]); \
        } \
        asm volatile("s_waitcnt lgkmcnt(0)" ::: "memory"); __builtin_amdgcn_s_barrier(); asm volatile("" ::: "memory"); \
        if (!lowhalf) { \
            _Pragma("unroll") for (int ks = 0; ks < 2; ++ks) { const bf16x8 uf = *(const LAS bf16x8*)(UT + r16 * 72 + ks * 32 + q4 * 8); acc = __builtin_amdgcn_mfma_f32_16x16x32_bf16(cur.fb[ks], uf, acc, 0, 0, 0); } \
            unsigned char* op = Obuf + (size_t)rowbase * 1024 + offO; \
            _Pragma("unroll") for (int rg = 0; rg < 4; ++rg) *(bf16_t*)(op + rg * ostep) = f2bf(acc[rg]); \
        } \
        _Pragma("unroll") for (int rg = 0; rg < 4; ++rg) Sacc[rg] *= gl; \
        _Pragma("unroll") for (int ks = 0; ks < 2; ++ks) { const bf16x8 uf = *(const LAS bf16x8*)(U2T + r16 * 72 + ks * 32 + q4 * 8); Sacc = __builtin_amdgcn_mfma_f32_16x16x32_bf16(cur.fc[ks], uf, Sacc, 0, 0, 0); } \
        *(LAS u32x2*)(ST + r16 * 136 + wid * 16 + q4 * 4) = (u32x2){pk2(Sacc[0], Sacc[1]), pk2(Sacc[2], Sacc[3])}; \
        if ((stepn) + 3 < 132) scan_load(ws, cur, f, (stepn) + 3, bh, dir, lowhalf, rowbase); \
    } while (0)
#pragma unroll 1
    for (int s0 = 0; s0 < 132; s0 += 3) {
        SCAN_STEP(ops[0], rbs[0], s0);
        SCAN_STEP(ops[1], rbs[1], s0 + 1);
        SCAN_STEP(ops[2], rbs[2], s0 + 2);
    }
#undef SCAN_STEP
    __syncthreads();
}

__device__ __forceinline__ void ya_rows(KP P, int l, int nrows, int gwave, int nwaves, int lane) {
    const bf16_t* OF = (const bf16_t*)(P->ws + A_OF); const bf16_t* OB = (const bf16_t*)(P->ws + A_OB); const bf16_t* Z = (const bf16_t*)(P->ws + A_Z);
    bf16_t* Y = (bf16_t*)(P->ws + A_Y); const float* gn = P->in[I_DNON] + l * 128;
    const float g0 = gn[2 * lane], g1 = gn[2 * lane + 1];
    for (int r0 = gwave; r0 < nrows; r0 += 2 * nwaves) {
        const int r1 = r0 + nwaves; const bool has1 = r1 < nrows; const int rr[2] = {r0, has1 ? r1 : r0};
        unsigned a[2][4], bb[2][4], z[2][4];
#pragma unroll
        for (int q = 0; q < 2; ++q)
#pragma unroll
            for (int hh = 0; hh < 4; ++hh) { const size_t off = (size_t)rr[q] * 512 + hh * 128 + 2 * lane; a[q][hh] = *(const unsigned*)(OF + off); bb[q][hh] = *(const unsigned*)(OB + off); z[q][hh] = *(const unsigned*)(Z + off); }
#pragma unroll
        for (int q = 0; q < 2; ++q)
#pragma unroll
            for (int hh = 0; hh < 4; ++hh) {
                const float o0 = lo2f(a[q][hh]) + lo2f(bb[q][hh]), o1 = hi2f(a[q][hh]) + hi2f(bb[q][hh]);
                const float ss = wave_sum(o0 * o0 + o1 * o1); const float rs = rsqrtf(ss * (1.0f / 128.0f) + EPS);
                if (q == 0 || has1) *(unsigned*)(Y + (size_t)rr[q] * 1280 + hh * 128 + 2 * lane) = pk2(o0 * rs * g0 * siluf(lo2f(z[q][hh])), o1 * rs * g1 * siluf(hi2f(z[q][hh]))); }
    }
}
__device__ __forceinline__ void tr_y_item(KP P, int it, bool ctx, LAS unsigned char* lds, int tid) {
    const int ntg = ctx ? 1 : 32; const int tg = it % ntg, ct = (it / ntg) % 12, b = it / (ntg * 12); const int nlen = ctx ? CTXL : SEQ;
    const bf16_t* src; int coloff;
    if (ct < 8) { src = (const bf16_t*)(P->ws + (ctx ? A_YBTC : A_YBT)) + ((size_t)(b * 512 + ct * 64)) * nlen; coloff = 512 + ct * 64; }
    else { src = (const bf16_t*)(P->ws + (ctx ? A_YCTC : A_YCT)) + ((size_t)(b * 256 + (ct - 8) * 64)) * nlen; coloff = 1024 + (ct - 8) * 64; }
    LAS bf16_t* t = (LAS bf16_t*)lds;
    const int chl = tid >> 3, seg = tid & 7;
    u32x4 v[4];
#pragma unroll
    for (int q = 0; q < 4; ++q) v[q] = *(const u32x4*)(src + (size_t)chl * nlen + (tg * 4 + q) * 64 + seg * 8);
    __syncthreads();
#pragma unroll
    for (int q = 0; q < 4; ++q) *(LAS u32x4*)(t + q * 64 * 72 + chl * 72 + seg * 8) = v[q];
    __syncthreads();
#pragma unroll
    for (int q = 0; q < 4; ++q) { const int tl = tid >> 3; unsigned w[4];
#pragma unroll
      for (int j = 0; j < 4; ++j) w[j] = (unsigned)t[q * 64 * 72 + (seg * 8 + 2 * j) * 72 + tl] | ((unsigned)t[q * 64 * 72 + (seg * 8 + 2 * j + 1) * 72 + tl] << 16);
      const size_t row = (ctx ? (size_t)NLAT + b * CTXL : (size_t)b * SEQ) + (tg * 4 + q) * 64 + tl;
      *(u32x4*)((bf16_t*)(P->ws + A_Y) + row * 1280 + coloff + seg * 8) = (u32x4){w[0], w[1], w[2], w[3]}; }
}

#ifndef PH
#define PH 0xFFFF
#endif
#define ON(k) ((PH >> (k)) & 1)
__device__ __forceinline__ int fresh_tid() { int t = threadIdx.x; asm volatile("" : "+v"(t)); return t; }
#ifndef REP2
#define REP2 1
#endif
#ifndef REP3
#define REP3 1
#endif
#ifndef REP4
#define REP4 1
#endif
#ifndef REP5
#define REP5 1
#endif
#ifndef REP7
#define REP7 1
#endif
#ifndef REP8
#define REP8 1
#endif
#ifndef REP11
#define REP11 1
#endif
#define TID fresh_tid()
#define FT const int bid = blockIdx.x, G = gridDim.x, nwaves = G * 8; (void)nwaves; KP P = (KP)__builtin_amdgcn_kernarg_segment_ptr(); asm volatile("" : "+s"(P)); unsigned char* ws = P->ws; (void)ws; const int tid = fresh_tid(); const int lane = tid & 63; const int gwave = bid * 8 + (tid >> 6); (void)lane; (void)gwave;
template <int L>
__device__ __forceinline__ void layer_body(LAS unsigned char* lds) {
    constexpr int l = L;
    constexpr bool first = (L == 0);
        const int M2 = first ? MALL : NLAT;
        if (ON(1)) { FT modulate_rows(P, l, 0, first, MALL, false, gwave, nwaves, lane);
          __syncthreads(); }
        GSYNC();
        { FT pg8::Gemm g{(const bf16_t*)(ws + A_XN), (const bf16_t*)(ws + WS_WIN), MALL, 3328, D}; pg8::StaticOrder S; S.init(MALL, 3328, G, bid);
          EpiMain E{ws}; for (int rep_ = 0; rep_ < REP2; ++rep_) pg8::gemm_phase<EpiMain>(lds, g, S, E, tid);
          { const int nbusy = (66 * 13) % G, nfree = G - nbusy;
            if (bid >= nbusy) { for (int it = bid - nbusy; it < 128 * 16; it += nfree) filt_item(P, l, it, false, lds, tid);
                                if (first) for (int it = bid - nbusy; it < 4 * 16; it += nfree) filt_item(P, l, it, true, lds, tid); }
            __syncthreads(); } }
        GSYNC();
        for (int rep_ = 0; rep_ < REP3; ++rep_) {
          { FT for (int j = bid; j < 256; j += G) hyena_job<14>(P, l, j, lds, tid); }
          { FT for (int j = bid; j < 256; j += G) fnet_job<13>(P, j, lds, tid); }
          if (first) {
            { FT for (int j = bid; j < 256; j += G) hyena_job<9>(P, l, j, lds, tid); }
            { FT for (int j = bid; j < 256; j += G) fnet_job<8>(P, j, lds, tid); }
          }
        }
        GSYNC();
        for (int rep_ = 0; rep_ < REP4; ++rep_) { FT if (G == 256) { for (int j = bid >> 3; j < 132; j += 32) { const int t2 = fresh_tid(); chunk_item(P, l, (bid & 7) * 132 + j, lds, t2); } } else { for (int it = bid; it < 1056; it += G) { const int t2 = fresh_tid(); chunk_item(P, l, it, lds, t2); } } }
        GSYNC();
        for (int rep_ = 0; rep_ < REP5; ++rep_) { FT if (bid < 128) phase_scan(P, lds, tid); else { for (int it = bid - 128; it < NCONV_F + NCONV_A_LATE; it += G - 128) { if (it < NCONV_F) conv_item_F(P, l, it, lds, tid); else conv_item_A(P, l, conv_a_late(it - NCONV_F), lds, tid); } } }
        GSYNC();
        if (ON(6)) { FT
        modulate_rows(P, l, 0, first, M2, false, gwave, nwaves, lane);
        ya_rows(P, l, M2, gwave, nwaves, lane);
        for (int it = bid; it < 2 * 12 * 32; it += G) tr_y_item(P, it, false, lds, tid);
        if (first) for (int it = bid; it < 2 * 12; it += G) tr_y_item(P, it, true, lds, tid);
        }
        __syncthreads();
        GSYNC();
        { FT pg8::Gemm g{(const bf16_t*)(ws + A_XN), (const bf16_t*)(ws + WS_WIN) + (size_t)3328 * D, M2, 3072, D}; pg8::StaticOrder S; S.init(M2, 3072, G, bid);
          EpiGate E{(bf16_t*)(ws + A_GATE)}; for (int rep_ = 0; rep_ < REP7; ++rep_) pg8::gemm_phase<EpiGate>(lds, g, S, E, tid); }
        GSYNC();
        { FT pg8::Gemm g{(const bf16_t*)(ws + A_Y), (const bf16_t*)(ws + WS_WABC), M2, D, 1280}; pg8::StaticOrder S; S.init(M2, D, G, bid);
          EpiMerge E{(const bf16_t*)(ws + A_GATE), (bf16_t*)(ws + A_XN)}; for (int rep_ = 0; rep_ < REP8; ++rep_) pg8::gemm_phase<EpiMerge>(lds, g, S, E, tid); }
        GSYNC();
        { FT const float* mod = (const float*)(ws + WS_MOD) + (size_t)l * 3 * 6144;
          pg8::Gemm g{(const bf16_t*)(ws + A_XN), (const bf16_t*)(ws + WS_WOUT), M2, D, D}; pg8::StaticOrder S; S.init(M2, D, G, bid);
          EpiRes E{first ? P->in[I_X] : P->out, first ? P->in[I_CTX] : (const float*)(ws + WS_HC), P->out, (float*)(ws + WS_HC), mod + 2 * D};
          if (ON(9)) pg8::gemm_phase<EpiRes>(lds, g, S, E, tid); }
        GSYNC();
        if (ON(10)) { FT modulate_rows(P, l, 1, false, M2, false, gwave, nwaves, lane);
 }
        __syncthreads();
        GSYNC();
        { FT pg8::Gemm g{(const bf16_t*)(ws + A_XN), (const bf16_t*)(ws + A_WF1), M2, DFF, D}; pg8::StaticOrder S; S.init(M2, DFF, G, bid);
          EpiRelu2 E{(bf16_t*)(ws + A_ACT)}; for (int rep_ = 0; rep_ < REP11; ++rep_) pg8::gemm_phase<EpiRelu2>(lds, g, S, E, tid);
          if (first) { const int nbusy = (66 * 16) % G, nfree = G - nbusy;
            if (bid >= nbusy) for (int it = bid - nbusy; it < NCONV_A_EARLY; it += nfree) conv_item_A(P, 1, conv_a_early(it), lds, tid);
            __syncthreads(); } }
        GSYNC();
        { FT const float* mod = (const float*)(ws + WS_MOD) + (size_t)l * 3 * 6144;
          pg8::Gemm g{(const bf16_t*)(ws + A_ACT), (const bf16_t*)(ws + A_WF2), NLAT, D, DFF}; pg8::StaticOrder S; S.init(NLAT, D, G, bid);
          EpiRes E{P->out, (const float*)(ws + WS_HC), P->out, (float*)(ws + WS_HC), mod + 5 * D};
          if (ON(12)) pg8::gemm_phase<EpiRes>(lds, g, S, E, tid);
          if (first) {
              pg8::Gemm g2{(const bf16_t*)(ws + A_ACT), (const bf16_t*)(ws + A_WF2), MALL, D, DFF, 4}; pg8::SplitOrder S2{G, bid};
              EpiPart E2{(float*)(ws + A_XN)};
              pg8::gemm_phase<EpiPart>(lds, g2, S2, E2, tid); } }
        GSYNC();
        if (first) { FT const float* mod = (const float*)(ws + WS_MOD) + (size_t)l * 3 * 6144 + 2 * 6144 + 5 * D; const float* part = (const float*)(ws + A_XN); float* hc = (float*)(ws + WS_HC);
          for (int idx = bid * NT + tid; idx < 512 * 256; idx += G * NT) { const int row = idx >> 8, c4 = (idx & 255) * 4; f32x4 a = (f32x4){0.f, 0.f, 0.f, 0.f};
#pragma unroll
              for (int ks = 0; ks < 16; ++ks) a += *(const f32x4*)(part + ((size_t)ks * 512 + row) * D + c4);
              const f32x4 mv = *(const f32x4*)(mod + c4); f32x4* o = (f32x4*)(hc + (size_t)row * D + c4); *o = *o + mv * a; }
          GSYNC(); }
    }

__global__ void __launch_bounds__(NT, 2) hybrid_fwd(Params Parg) {
    extern __shared__ __attribute__((aligned(16))) unsigned char lds_raw[];
    LAS unsigned char* lds = (LAS unsigned char*)lds_raw;

    if (threadIdx.x < 4) ((volatile LAS unsigned*)(lds + LDS_BARW))[threadIdx.x] = 0u;
    __syncthreads();
    if (threadIdx.x == 0) (void)xb_add(&((unsigned*)(((KP)__builtin_amdgcn_kernarg_segment_ptr())->ws + WS_BAR))[XB_XCNT(xb_xcc_id())], 1u);
    { FT
    for (int it = bid; it < 384 + 32 + 260 + NCONV_A_EARLY; it += G) {
        if (!ON(0)) continue;
        if (it < 384) modp_item(P, it, tid);
        else if (it < 416) { }
        else if (it < 676) hid2_item(P, it - 416, lds, tid);
        else conv_item_A(P, 0, conv_a_early(it - 676), lds, tid);
    } }
    cg::this_grid().sync();
    { FT
    for (int idx = bid * NT + tid; idx < 2 * 3 * 6144; idx += G * NT) { const int n = idx % 6144, lv = idx / 6144, l = lv / 3;
        float a = P->in[I_BMOD][l * 6144 + n]; const float* mp = (const float*)(ws + WS_MODP) + idx;
        for (int kc = 0; kc < 16; ++kc) a += mp[(size_t)kc * 2 * 3 * 6144];
        ((float*)(ws + WS_MOD))[idx] = a; } }
    GSYNC();

    layer_body<0>(lds);
    layer_body<1>(lds);
    { FT const float* gain = P->in[I_FNORM];
      f32x4 g[4];
#pragma unroll
      for (int i = 0; i < 4; ++i) g[i] = *(const f32x4*)(gain + i * 256 + lane * 4);
      for (int r0 = gwave; r0 < NLAT; r0 += 2 * nwaves) { const int r1 = r0 + nwaves; const bool has1 = r1 < NLAT;
          float* h0 = P->out + (size_t)r0 * D; float* h1 = P->out + (size_t)(has1 ? r1 : r0) * D; f32x4 x0[4], x1[4]; float s0 = 0.f, s1 = 0.f;
#pragma unroll
          for (int i = 0; i < 4; ++i) { x0[i] = *(const f32x4*)(h0 + i * 256 + lane * 4); x1[i] = *(const f32x4*)(h1 + i * 256 + lane * 4); }
#pragma unroll
          for (int i = 0; i < 4; ++i) { s0 += x0[i][0] * x0[i][0] + x0[i][1] * x0[i][1] + x0[i][2] * x0[i][2] + x0[i][3] * x0[i][3]; s1 += x1[i][0] * x1[i][0] + x1[i][1] * x1[i][1] + x1[i][2] * x1[i][2] + x1[i][3] * x1[i][3]; }
          for (int o = 32; o >= 1; o >>= 1) { s0 += __shfl_xor(s0, o); s1 += __shfl_xor(s1, o); }
          const float q0 = rsqrtf(s0 * (1.0f / D) + EPS), q1 = rsqrtf(s1 * (1.0f / D) + EPS);
#pragma unroll
          for (int i = 0; i < 4; ++i) { *(f32x4*)(h0 + i * 256 + lane * 4) = x0[i] * q0 * g[i]; if (has1) *(f32x4*)(h1 + i * 256 + lane * 4) = x1[i] * q1 * g[i]; } } }
}

extern "C" void kernel_launch(void* const* d_in, const int* in_sizes, int n_in, void* d_out, int out_size, void* d_ws, size_t ws_size, hipStream_t stream) {
    static int grid_blocks = 0;
    if (!grid_blocks) {
        int dev = 0, cus = 0, per_cu = 0;
        (void)hipGetDevice(&dev);
        (void)hipDeviceGetAttribute(&cus, hipDeviceAttributeMultiprocessorCount, dev);
        (void)hipFuncSetAttribute((const void*)hybrid_fwd, hipFuncAttributeMaxDynamicSharedMemorySize, LDS_BYTES);
        (void)hipOccupancyMaxActiveBlocksPerMultiprocessor(&per_cu, (const void*)hybrid_fwd, NT, LDS_BYTES);
        if (per_cu < 1) per_cu = 1;
        grid_blocks = cus * 1;
        if (ws_size < 256 * MiB) fprintf(stderr, "kernel_launch: workspace too small (%zu)\n", ws_size);
    }
    Params p{};
    for (int i = 0; i < 29; ++i) p.in[i] = (const float*)d_in[i];
    p.out = (float*)d_out; p.ws = (unsigned char*)d_ws;
    (void)hipMemsetAsync((unsigned char*)d_ws + WS_BAR, 0, 16384, stream);
    void* args[] = {&p};
    hipError_t e = hipLaunchCooperativeKernel((const void*)hybrid_fwd, dim3(grid_blocks), dim3(NT), args, LDS_BYTES, stream);
    if (e != hipSuccess) fprintf(stderr, "cooperative launch failed: %s (grid %d)\n", hipGetErrorString(e), grid_blocks);
}
```
